# Optimizing an MI355X kernel written in HIP

```python
import jax, jax.numpy as jnp
from jax import lax
import numpy as np

D_MODEL = 1024
BATCH = 8
SEQ = 2048
DEPTH = 2

GRID_W = 64
CTX_LEN = 256
D_LRU = D_MODEL // 2
D_CONV = D_MODEL - D_LRU
LRU_HEADS = 8
LRU_HEAD_DIM = D_LRU // LRU_HEADS
CONV_GROUPS = 8
D_IN = 2 * D_LRU + 3 * D_CONV
D_FF = 4 * D_MODEL
LRU_CONV_W = 4
SHORT_CONV_W = 3
RG_C = 8.0
N_MOD = 6
EPS = 1e-6

kernel_name = 'hybrid_rglru_shortconv_prefix_dit_block'


def _rmsnorm(x, g):
    xf = x.astype(jnp.float32)
    y = xf * lax.rsqrt(jnp.mean(xf * xf, axis=-1, keepdims=True) + EPS)
    return (y * g.astype(jnp.float32)).astype(x.dtype)


def _modulate(h, shift, scale):
    return h * (1 + scale) + shift


def _dwconv1d(v, w, pad_lo, pad_hi):
    return lax.conv_general_dilated(v, w[:, None, :].astype(v.dtype), window_strides=(1,),
                                    padding=[(pad_lo, pad_hi)],
                                    dimension_numbers=('NWC', 'WIO', 'NWC'),
                                    feature_group_count=v.shape[-1])


def _dwconv2d(v, w):
    kh, kw, ch = w.shape
    return lax.conv_general_dilated(v, w[:, :, None, :].astype(v.dtype), window_strides=(1, 1),
                                    padding=[((kh - 1) // 2, kh // 2), ((kw - 1) // 2, kw // 2)],
                                    dimension_numbers=('NHWC', 'HWIO', 'NHWC'),
                                    feature_group_count=ch)


def _combine(e1, e2):
    a1, b1 = e1
    a2, b2 = e2
    return a1 * a2, a2 * b1 + b2


def _linear_scan(a, b, h0, reverse):
    if h0 is not None:
        edge = -1 if reverse else 0
        b = b.at[:, edge].add(a[:, edge] * h0)
    _, h = lax.associative_scan(_combine, (a, b), reverse=reverse, axis=1)
    return h


def _rglru_coeffs(v, w_a, b_a, w_x, b_x, lam):
    vf = v.astype(jnp.float32)
    vh = vf.reshape(vf.shape[:-1] + (LRU_HEADS, LRU_HEAD_DIM))
    r = jax.nn.sigmoid(jnp.einsum('bshd,hde->bshe', vh, w_a.astype(jnp.float32)).reshape(vf.shape)
                       + b_a.astype(jnp.float32))
    i = jax.nn.sigmoid(jnp.einsum('bshd,hde->bshe', vh, w_x.astype(jnp.float32)).reshape(vf.shape)
                       + b_x.astype(jnp.float32))
    log_a = -RG_C * r * jax.nn.softplus(-lam.astype(jnp.float32))
    a = jnp.exp(log_a)
    b = jnp.sqrt(-jnp.expm1(2.0 * log_a)) * (i * vf)
    return a, b


def _token_mixers(h_lat, h_ctx, w_in, conv4_w, conv4_b, gate_a_w, gate_a_b, gate_x_w, gate_x_b,
                  rg_lambda, conv3_w, g_out_lru, g_out_conv, w_out, ctx_out):
    bsz, seq, _ = h_lat.shape
    rows = seq // GRID_W
    dt = h_lat.dtype
    u_lat = h_lat @ w_in
    u_ctx = h_ctx @ (w_in if ctx_out else w_in[:, :D_LRU])

    v_lat = _dwconv1d(u_lat[..., :D_LRU], conv4_w, 1, 2) + conv4_b
    v_ctx = _dwconv1d(u_ctx[..., :D_LRU], conv4_w, 1, 2) + conv4_b
    hs_lat, hs_ctx = [], []
    for d, rev in enumerate((False, True)):
        a_c, b_c = _rglru_coeffs(v_ctx, gate_a_w[d], gate_a_b[d], gate_x_w[d], gate_x_b[d], rg_lambda[d])
        hc = _linear_scan(a_c, b_c, None, rev)
        h0 = hc[:, 0] if rev else hc[:, -1]
        a_l, b_l = _rglru_coeffs(v_lat, gate_a_w[d], gate_a_b[d], gate_x_w[d], gate_x_b[d], rg_lambda[d])
        hs_lat.append(_linear_scan(a_l, b_l, h0, rev))
        if ctx_out:
            hs_ctx.append(hc)
    y_lru_lat = jax.nn.gelu(u_lat[..., D_LRU:2 * D_LRU]) * (hs_lat[0] + hs_lat[1]).astype(dt)

    o = 2 * D_LRU
    xc, bg, cg = u_lat[..., o:o + D_CONV], u_lat[..., o + D_CONV:o + 2 * D_CONV], u_lat[..., o + 2 * D_CONV:]
    half = D_CONV // 2
    v = (cg * xc).reshape(bsz, rows, GRID_W, D_CONV)
    conv_row = _dwconv2d(v[..., :half], conv3_w[None, :, :half])
    conv_col = _dwconv2d(v[..., half:], conv3_w[:, None, half:])
    y_conv_lat = bg * jnp.concatenate([conv_row, conv_col], axis=-1).reshape(bsz, seq, D_CONV)

    out_lat = jnp.concatenate([_rmsnorm(y_lru_lat, g_out_lru), _rmsnorm(y_conv_lat, g_out_conv)], axis=-1) @ w_out
    if not ctx_out:
        return out_lat, None

    y_lru_ctx = jax.nn.gelu(u_ctx[..., D_LRU:2 * D_LRU]) * (hs_ctx[0] + hs_ctx[1]).astype(dt)
    xc_c, bg_c, cg_c = u_ctx[..., o:o + D_CONV], u_ctx[..., o + D_CONV:o + 2 * D_CONV], u_ctx[..., o + 2 * D_CONV:]
    y_conv_ctx = bg_c * _dwconv1d(cg_c * xc_c, conv3_w, 1, 1)
    out_ctx = jnp.concatenate([_rmsnorm(y_lru_ctx, g_out_lru), _rmsnorm(y_conv_ctx, g_out_conv)], axis=-1) @ w_out
    return out_lat, out_ctx


def _sq_relu_mlp(h, w1, w2):
    return jnp.square(jax.nn.relu(h @ w1)) @ w2


def setup_inputs(seed: int = 0) -> dict:
    key = jax.random.key(seed)
    ks = jax.random.split(key, 24)
    f32 = jnp.float32

    def nrm(k, shape, scale):
        return jax.random.normal(k, shape, f32) * scale

    u = jax.random.uniform(ks[13], (DEPTH, 2, D_LRU), f32, 0.9, 0.999)
    a_base = u ** (1.0 / RG_C)
    return {
        'x': nrm(ks[0], (BATCH, SEQ, D_MODEL), 1.0),
        'c': nrm(ks[1], (BATCH, D_MODEL), 1.0),
        'ctx': nrm(ks[2], (BATCH, CTX_LEN, D_MODEL), 1.0),
        'c_ctx': nrm(ks[3], (D_MODEL,), 1.0),
        'ada_w': nrm(ks[4], (DEPTH, D_MODEL, N_MOD * D_MODEL), 0.5 * D_MODEL ** -0.5),
        'ada_b': nrm(ks[5], (DEPTH, N_MOD * D_MODEL), 0.02),
        'norm1_g': 1.0 + nrm(ks[6], (DEPTH, D_MODEL), 0.02),
        'norm2_g': 1.0 + nrm(ks[7], (DEPTH, D_MODEL), 0.02),
        'w_in': nrm(ks[8], (DEPTH, D_MODEL, D_IN), D_MODEL ** -0.5),
        'conv4_w': nrm(ks[9], (DEPTH, LRU_CONV_W, D_LRU), LRU_CONV_W ** -0.5),
        'conv4_b': nrm(ks[10], (DEPTH, D_LRU), 0.02),
        'gate_a_w': nrm(ks[11], (DEPTH, 2, LRU_HEADS, LRU_HEAD_DIM, LRU_HEAD_DIM), LRU_HEAD_DIM ** -0.5),
        'gate_a_b': nrm(ks[12], (DEPTH, 2, D_LRU), 0.02),
        'gate_x_w': nrm(ks[14], (DEPTH, 2, LRU_HEADS, LRU_HEAD_DIM, LRU_HEAD_DIM), LRU_HEAD_DIM ** -0.5),
        'gate_x_b': nrm(ks[15], (DEPTH, 2, D_LRU), 0.02),
        'rg_lambda': jnp.log(a_base) - jnp.log1p(-a_base),
        'conv3_w': nrm(ks[16], (DEPTH, SHORT_CONV_W, D_CONV), SHORT_CONV_W ** -0.5),
        'g_out_lru': 1.0 + nrm(ks[17], (DEPTH, D_LRU), 0.02),
        'g_out_conv': 1.0 + nrm(ks[18], (DEPTH, D_CONV), 0.02),
        'w_out': nrm(ks[19], (DEPTH, D_MODEL, D_MODEL), D_MODEL ** -0.5),
        'w_mlp1': nrm(ks[20], (DEPTH, D_MODEL, D_FF), D_MODEL ** -0.5),
        'w_mlp2': nrm(ks[21], (DEPTH, D_FF, D_MODEL), D_FF ** -0.5),
        'final_g': 1.0 + nrm(ks[22], (D_MODEL,), 0.02),
    }


def reference(x, c, ctx, c_ctx, ada_w, ada_b, norm1_g, norm2_g, w_in, conv4_w, conv4_b, gate_a_w, gate_a_b,
              gate_x_w, gate_x_b, rg_lambda, conv3_w, g_out_lru, g_out_conv, w_out, w_mlp1, w_mlp2, final_g):
    silu_c = jax.nn.silu(c)
    silu_cc = jax.nn.silu(c_ctx)
    for l in range(DEPTH):
        last = l == DEPTH - 1
        mod_lat = (silu_c @ ada_w[l] + ada_b[l])[:, None, :]
        mod_ctx = silu_cc @ ada_w[l] + ada_b[l]
        sh1, sc1, g1, sh2, sc2, g2 = jnp.split(mod_lat, N_MOD, axis=-1)
        sh1c, sc1c, g1c, sh2c, sc2c, g2c = jnp.split(mod_ctx, N_MOD, axis=-1)

        h_lat = _modulate(_rmsnorm(x, norm1_g[l]), sh1, sc1)
        h_ctx = _modulate(_rmsnorm(ctx, norm1_g[l]), sh1c, sc1c)
        mix_lat, mix_ctx = _token_mixers(h_lat, h_ctx, w_in[l], conv4_w[l], conv4_b[l], gate_a_w[l], gate_a_b[l],
                                         gate_x_w[l], gate_x_b[l], rg_lambda[l], conv3_w[l], g_out_lru[l],
                                         g_out_conv[l], w_out[l], not last)
        x = x + g1 * mix_lat
        x = x + g2 * _sq_relu_mlp(_modulate(_rmsnorm(x, norm2_g[l]), sh2, sc2), w_mlp1[l], w_mlp2[l])
        if not last:
            ctx = ctx + g1c * mix_ctx
            ctx = ctx + g2c * _sq_relu_mlp(_modulate(_rmsnorm(ctx, norm2_g[l]), sh2c, sc2c), w_mlp1[l], w_mlp2[l])
    return _rmsnorm(x, final_g)
```

```cpp
#include <hip/hip_runtime.h>
#include <hip/hip_cooperative_groups.h>
#include <cstdio>
#include <cstdint>
namespace cg = cooperative_groups;
namespace pg8 {
#define PG8_LAS __attribute__((address_space(3)))
typedef unsigned short bf16_t;
typedef short bf16x8 __attribute__((ext_vector_type(8)));
typedef float f32x4 __attribute__((ext_vector_type(4)));
typedef unsigned u32x4 __attribute__((ext_vector_type(4)));
constexpr int BM = 256, BK = 64, HALF = 128, HTB = HALF * BK * 2  , STAGE_BYTES = 8 * HTB, NXCD = 8, WGM = 8;

__host__ __device__ __forceinline__ int lds_byte(int r, int c) { const int st = (r >> 4) * 2 + (c >> 5), rr = r & 15, cc = c & 31, ob = rr * 64 + cc * 2; return st * 1024 + (ob ^ (((ob >> 9) & 1) << 5)); }
__host__ __device__ __forceinline__ void stage_rc(int b, int& R, int& C) { const int st = b / 1024, sb = b % 1024, swz = sb ^ (((sb >> 9) & 1) << 5); R = (st >> 1) * 16 + swz / 64; C = (st & 1) * 32 + (swz % 64) / 2; }
__host__ __device__ __forceinline__ int perm32(int rho) { const int n = rho >> 4, i = rho & 15; return 8 * (i >> 2) + 4 * n + (i & 3); }

struct Unit { int pm, pn; };
struct Gemm { const bf16_t* A; const bf16_t* Bt; int M, N, K; };

struct StaticOrder {
    int nM, nN, nwg, G, c;
    __host__ __device__ void init(int M, int N, int G_, int c_) { nM = M / BM; nN = N / BM; nwg = nM * nN; G = G_; c = c_; }
    __host__ __device__ bool next(int i, Unit& u) const {
        const long L = (long)i * G + c; if (L >= nwg) return false;
        int wgid = (int)L; { const int q = nwg / NXCD, r = nwg % NXCD, xcd = wgid % NXCD, off = wgid / NXCD; wgid = (xcd < r ? xcd * (q + 1) : r * (q + 1) + (xcd - r) * q) + off; }
        const int nig = WGM * nN, gid = wgid / nig, fm = gid * WGM, gsz = (nM - fm) < WGM ? (nM - fm) : WGM;
        u.pm = fm + ((wgid % nig) % gsz); u.pn = (wgid % nig) / gsz; return true;
    }
    __device__ __forceinline__ void a_ready(const Unit&) const {}
    __device__ __forceinline__ void done(const Unit&) const {}
};

__device__ __forceinline__ unsigned cvt_pk_bf16(float lo, float hi) { unsigned r; asm volatile("v_cvt_pk_bf16_f32 %0, %1, %2" : "=v"(r) : "v"(lo), "v"(hi)); return r; }
typedef float f32x2 __attribute__((ext_vector_type(2)));
struct Order {
    int nM, nN, nwg, G, c, xM0, nX;
    __device__ void init(int nM_, int nN_, int G_, int c_, int xM0_, int nX_) { nM = nM_; nN = nN_; nwg = nM * nN; G = G_; c = c_; xM0 = xM0_; nX = nX_; }
    __device__ bool next(int i, Unit& u) const {
        const long L = (long)i * G + c;
        if (L >= nwg) { const int j = (int)(L - nwg); if (j >= nX) return false; u.pm = xM0 + (j & 7); u.pn = j >> 3; return true; }
        int wgid = (int)L; { const int q = nwg / NXCD, r = nwg % NXCD, xcd = wgid % NXCD, off = wgid / NXCD; wgid = (xcd < r ? xcd * (q + 1) : r * (q + 1) + (xcd - r) * q) + off; }
        const int nig = WGM * nN, gid = wgid / nig, fm = gid * WGM, gsz = (nM - fm) < WGM ? (nM - fm) : WGM;
        u.pm = fm + ((wgid % nig) % gsz); u.pn = (wgid % nig) / gsz; return true;
    }
    __device__ __forceinline__ void a_ready(const Unit&) const {}
    __device__ __forceinline__ void done(const Unit&) const {}
};

constexpr int ROWS_LAT = 16384;
constexpr float RMS_EPS = 1e-6f;

template <int ACT> struct EpiLin {
    static constexpr bool PERM = true, AFTER_DRAIN = false, MIDK = false;
    bf16_t* O; int ldc; const float* bias; int nb; const float* ssq;
    __device__ __forceinline__ void midk(f32x4 (&)[2][2][4][2], const Unit&, int, int, int, int) const {}
    __device__ __forceinline__ void operator()(const f32x4 (&acc)[2][2][4][2], const Unit& u, int wr, int wc, int fr, int fq) const {
        asm volatile("" : "+v"(fr), "+v"(fq));
        const int b = u.pm < 64 ? (u.pm >> 3) : 8;
        const int row0 = u.pm * BM + wr * 64 + fr, col0 = u.pn * BM + wc * 32 + 8 * fq;
        f32x4 bv[2][2];
#pragma unroll
        for (int bj = 0; bj < 2; ++bj)
#pragma unroll
            for (int n = 0; n < 2; ++n) bv[bj][n] = *(const f32x4*)(bias + (size_t)b * nb + col0 + bj * HALF + 4 * n);
#pragma unroll
        for (int ai = 0; ai < 2; ++ai)
#pragma unroll
            for (int m = 0; m < 4; ++m) {
                const int row = row0 + ai * HALF + m * 16;
                const f32x4 p = *(const f32x4*)(ssq + (size_t)row * 16 + 4 * fq);
                float s = (p[0] + p[1]) + (p[2] + p[3]); s += __shfl_xor(s, 16); s += __shfl_xor(s, 32);
                const float rs = __builtin_amdgcn_rsqf(s * (1.0f / 1024.0f) + RMS_EPS);
                bf16_t* rowp = O + (size_t)row * ldc + col0;
#pragma unroll
                for (int bj = 0; bj < 2; ++bj) {
                    f32x4 v0 = acc[ai][bj][m][0] * rs + bv[bj][0], v1 = acc[ai][bj][m][1] * rs + bv[bj][1];
                    if (ACT == 1) {
#pragma unroll
                        for (int j = 0; j < 4; ++j) { const float a = fmaxf(v0[j], 0.f), c = fmaxf(v1[j], 0.f); v0[j] = a * a; v1[j] = c * c; }
                    }
                    u32x4 w; w.x = cvt_pk_bf16(v0[0], v0[1]); w.y = cvt_pk_bf16(v0[2], v0[3]); w.z = cvt_pk_bf16(v1[0], v1[1]); w.w = cvt_pk_bf16(v1[2], v1[3]);
                    *(u32x4*)(rowp + bj * HALF) = w;
                }
                asm volatile("" ::: "memory");
            }
    }
};

template <bool MID> struct EpiRes {
    static constexpr bool PERM = true, AFTER_DRAIN = false, MIDK = MID;
    const float* xin_lat; const float* xin_ctx; float* xout_lat; float* xout_ctx;
    const float* gate;
    const float* nsc;
    const float* ng;
    bf16_t* xs; float* ssq; const float* ysl; const float* ysc;
    __device__ __forceinline__ void midk(f32x4 (&acc)[2][2][4][2], const Unit& u, int wr, int wc, int fr, int fq) const {
        asm volatile("" : "+v"(fr));
        const int row0 = u.pm * BM + wr * 64 + fr;
#pragma unroll
        for (int ai = 0; ai < 2; ++ai)
#pragma unroll
            for (int m = 0; m < 4; ++m) {
                const int row = row0 + ai * HALF + m * 16;
                const f32x4 a = *(const f32x4*)(ysl + (size_t)row * 8), c = *(const f32x4*)(ysl + (size_t)row * 8 + 4);
                const float sl = ((a[0] + a[1]) + (a[2] + a[3])) + ((c[0] + c[1]) + (c[2] + c[3]));
                const float rl = __builtin_amdgcn_rsqf(sl * (1.0f / 512.0f) + RMS_EPS);
                const float qc = ysc[row] * (1.0f / 512.0f) + RMS_EPS;
                const float ratio = rl * __builtin_amdgcn_sqrtf(qc);
#pragma unroll
                for (int bj = 0; bj < 2; ++bj)
#pragma unroll
                    for (int n = 0; n < 2; ++n) acc[ai][bj][m][n] = acc[ai][bj][m][n] * ratio;
                asm volatile("" ::: "memory");
            }
    }
    __device__ __forceinline__ void operator()(const f32x4 (&acc)[2][2][4][2], const Unit& u, int wr, int wc, int fr, int fq) const {
        asm volatile("" : "+v"(fr), "+v"(fq));
        const bool lat = u.pm < 64;
        const int b = lat ? (u.pm >> 3) : 8;
        const int row0 = u.pm * BM + wr * 64 + fr, col0 = u.pn * BM + wc * 32 + 8 * fq;
        const int rbase = lat ? 0 : ROWS_LAT;
        const float* xi = lat ? xin_lat : xin_ctx; float* xo = lat ? xout_lat : xout_ctx;
        f32x4 gv[2][2], nv[2][2];
#pragma unroll
        for (int bj = 0; bj < 2; ++bj)
#pragma unroll
            for (int n = 0; n < 2; ++n) {
                const int c = col0 + bj * HALF + 4 * n;
                gv[bj][n] = *(const f32x4*)(gate + (size_t)b * 6144 + c);
                if (nsc) { const f32x4 s = *(const f32x4*)(nsc + (size_t)b * 6144 + c), g = *(const f32x4*)(ng + c); nv[bj][n] = g * (s + 1.0f); }
                else nv[bj][n] = (f32x4){0.f, 0.f, 0.f, 0.f};
            }
#pragma unroll
        for (int ai = 0; ai < 2; ++ai)
#pragma unroll
            for (int m = 0; m < 4; ++m) {
                const int row = row0 + ai * HALF + m * 16;
                float send = 1.0f;
                if (MID) send = __builtin_amdgcn_rsqf(ysc[row] * (1.0f / 512.0f) + RMS_EPS);
                const size_t off = (size_t)(row - rbase) * 1024 + col0;
                float ss = 0.f;
#pragma unroll
                for (int bj = 0; bj < 2; ++bj) {
                    const f32x4 x0 = *(const f32x4*)(xi + off + bj * HALF), x1 = *(const f32x4*)(xi + off + bj * HALF + 4);
                    const f32x4 y0 = x0 + gv[bj][0] * (acc[ai][bj][m][0] * send), y1 = x1 + gv[bj][1] * (acc[ai][bj][m][1] * send);
                    *(f32x4*)(xo + off + bj * HALF) = y0; *(f32x4*)(xo + off + bj * HALF + 4) = y1;
                    ss += (y0[0] * y0[0] + y0[1] * y0[1]) + (y0[2] * y0[2] + y0[3] * y0[3]);
                    ss += (y1[0] * y1[0] + y1[1] * y1[1]) + (y1[2] * y1[2] + y1[3] * y1[3]);
                    if (nsc) {
                        const f32x4 z0 = y0 * nv[bj][0], z1 = y1 * nv[bj][1];
                        u32x4 w; w.x = cvt_pk_bf16(z0[0], z0[1]); w.y = cvt_pk_bf16(z0[2], z0[3]); w.z = cvt_pk_bf16(z1[0], z1[1]); w.w = cvt_pk_bf16(z1[2], z1[3]);
                        *(u32x4*)(xs + (size_t)row * 1024 + col0 + bj * HALF) = w;
                    }
                }
                ss += __shfl_xor(ss, 16); ss += __shfl_xor(ss, 32);
                if (fq == 0) ssq[(size_t)row * 16 + u.pn * 4 + wc] = ss;
                asm volatile("" ::: "memory");
            }
    }
};

template <class Epi, class Sched, bool ALIGN_EPI = false, bool SP2 = false>
__device__ __forceinline__ void gemm_phase(PG8_LAS unsigned char* lds, const Gemm g, const Sched& S, const Epi& E) {
    int tid_ = threadIdx.x; asm volatile("" : "+v"(tid_));
    const int tid = tid_, wid = __builtin_amdgcn_readfirstlane(tid >> 6), lane = tid & 63, wr = wid >> 2, wc = wid & 3, fr = lane & 15, fq = lane >> 4;
    const int K = g.K, nt = K / BK;
    unsigned voffA[2], voffB[2];
#pragma unroll
    for (int i = 0; i < 2; ++i) { int R, C; stage_rc(tid * 16 + i * 8192, R, C); const int Rb = Epi::PERM ? ((R & ~31) + perm32(R & 31)) : R;
        voffA[i] = (unsigned)(R * K + C) * 2u; voffB[i] = (unsigned)(Rb * K + C) * 2u; }
    const size_t kstep = (size_t)(BK * 2);
    const size_t hstep = (size_t)HALF * K * 2;
    const size_t tstep = 2 * hstep;
    const unsigned ldsw = (unsigned)wid * 1024u;
    const int aoff = lds_byte(wr * 64 + fr, fq * 8), boff = lds_byte(wc * 32 + fr, fq * 8);
#define PG8_SA(b, h) (((b) * 2 + (h)) * HTB)
#define PG8_SB(b, h) ((4 + (b) * 2 + (h)) * HTB)
#define PG8_STAGE(bufoff, gbase, voff) do { _Pragma("unroll") for (int _i = 0; _i < 2; ++_i) \
        __builtin_amdgcn_global_load_lds((const unsigned*)((const char*)(gbase) + (voff)[_i]), (PG8_LAS unsigned*)(lds + (bufoff) + ldsw + _i * 8192), 16, 0, 0); } while (0)
#define PG8_LDA(dst, b, h) do { _Pragma("unroll") for (int m = 0; m < 4; ++m) _Pragma("unroll") for (int k = 0; k < 2; ++k) dst[m][k] = *(const PG8_LAS bf16x8*)(lds + PG8_SA(b, h) + aoff + m * 2048 + k * 1024); } while (0)
#define PG8_LDB(dst, b, h) do { _Pragma("unroll") for (int n = 0; n < 2; ++n) _Pragma("unroll") for (int k = 0; k < 2; ++k) dst[n][k] = *(const PG8_LAS bf16x8*)(lds + PG8_SB(b, h) + boff + n * 2048 + k * 1024); } while (0)
#define PG8_MMA(ai, bj, At, Bt) do { __builtin_amdgcn_s_setprio(1); _Pragma("unroll") for (int m = 0; m < 4; ++m) _Pragma("unroll") for (int n = 0; n < 2; ++n) _Pragma("unroll") for (int k = 0; k < 2; ++k) \
        acc[ai][bj][m][n] = __builtin_amdgcn_mfma_f32_16x16x32_bf16(Bt[n][k], At[m][k], acc[ai][bj][m][n], 0, 0, 0); __builtin_amdgcn_s_setprio(0); } while (0)
#define PG8_WAIT_V(n) asm volatile("s_waitcnt vmcnt(" #n ")" ::: "memory")
#define PG8_WAIT_L(n) asm volatile("s_waitcnt lgkmcnt(" #n ")" ::: "memory")
#define PG8_BAR __builtin_amdgcn_s_barrier()
#define PG8_SCHED __builtin_amdgcn_sched_barrier(0)
    Unit cur, nxt; int ui = 0;
    if (!S.next(0, cur)) return;
    f32x4 acc[2][2][4][2];
#pragma unroll
    for (int a = 0; a < 2; ++a)
#pragma unroll
        for (int b = 0; b < 2; ++b)
#pragma unroll
            for (int m = 0; m < 4; ++m)
#pragma unroll
                for (int n = 0; n < 2; ++n) acc[a][b][m][n] = (f32x4){0.f, 0.f, 0.f, 0.f};
    bf16x8 At[4][2], B0[2][2], B1[2][2];
    const char* cA = (const char*)g.A + (size_t)cur.pm * tstep; const char* cB = (const char*)g.Bt + (size_t)cur.pn * tstep;
    S.a_ready(cur);
    if constexpr (SP2) {
        PG8_STAGE(PG8_SB(0, 0), cB, voffB); PG8_STAGE(PG8_SB(0, 1), cB + hstep, voffB); PG8_STAGE(PG8_SA(0, 0), cA, voffA); PG8_STAGE(PG8_SA(0, 1), cA + hstep, voffA);
        if (wr == 1) PG8_BAR;
        PG8_WAIT_V(2); PG8_BAR;
        PG8_STAGE(PG8_SB(1, 0), cB + kstep, voffB); PG8_STAGE(PG8_SA(1, 0), cA + kstep, voffA); PG8_STAGE(PG8_SB(1, 1), cB + hstep + kstep, voffB);
        PG8_WAIT_V(6); PG8_BAR;
    } else {
        PG8_STAGE(PG8_SB(0, 0), cB, voffB); PG8_STAGE(PG8_SA(0, 0), cA, voffA); PG8_STAGE(PG8_SB(0, 1), cB + hstep, voffB); PG8_STAGE(PG8_SA(0, 1), cA + hstep, voffA);
        if (wr == 1) PG8_BAR;
        PG8_WAIT_V(4); PG8_BAR;
        PG8_STAGE(PG8_SB(1, 0), cB + kstep, voffB); PG8_STAGE(PG8_SA(1, 0), cA + kstep, voffA); PG8_STAGE(PG8_SB(1, 1), cB + hstep + kstep, voffB);
        PG8_WAIT_V(6); PG8_BAR;
    }
    for (;;) {
        const bool has_next = S.next(ui + 1, nxt);
        const char* nA = has_next ? (const char*)g.A + (size_t)nxt.pm * tstep : cA; const char* nB = has_next ? (const char*)g.Bt + (size_t)nxt.pn * tstep : cB;
        for (int t = 0; t < nt; t += 2) {
            const bool last = (t == nt - 2);
            if constexpr (Epi::MIDK) { if (t == (nt >> 1)) E.midk(acc, cur, wr, wc, fr, fq); }
            const char* a1 = cA + (size_t)(t + 1) * kstep;
            const char* a2 = last ? nA : cA + (size_t)(t + 2) * kstep; const char* b2 = last ? nB : cB + (size_t)(t + 2) * kstep;
            const char* a3 = a2 + kstep; const char* b3 = b2 + kstep;
            if (last && has_next) S.a_ready(nxt);
            if constexpr (SP2) {
            PG8_LDB(B0, 0, 0); PG8_LDB(B1, 0, 1); PG8_SCHED; PG8_LDA(At, 0, 0); PG8_STAGE(PG8_SA(1, 1), a1 + hstep, voffA);
            PG8_WAIT_V(8); PG8_WAIT_L(0); PG8_BAR; PG8_MMA(0, 0, At, B0); PG8_MMA(0, 1, At, B1); PG8_BAR; PG8_SCHED;
            PG8_LDA(At, 0, 1); PG8_STAGE(PG8_SB(0, 0), b2, voffB); PG8_STAGE(PG8_SB(0, 1), b2 + hstep, voffB); PG8_STAGE(PG8_SA(0, 0), a2, voffA);
            PG8_WAIT_V(8); PG8_WAIT_L(0); PG8_BAR; PG8_MMA(1, 0, At, B0); PG8_MMA(1, 1, At, B1); PG8_BAR; PG8_SCHED;
            PG8_LDB(B0, 1, 0); PG8_LDB(B1, 1, 1); PG8_SCHED; PG8_LDA(At, 1, 0); PG8_STAGE(PG8_SA(0, 1), a2 + hstep, voffA);
            PG8_WAIT_V(8); PG8_WAIT_L(0); PG8_BAR; PG8_MMA(0, 0, At, B0); PG8_MMA(0, 1, At, B1); PG8_BAR; PG8_SCHED;
            PG8_LDA(At, 1, 1); PG8_STAGE(PG8_SB(1, 0), b3, voffB); PG8_STAGE(PG8_SB(1, 1), b3 + hstep, voffB); PG8_STAGE(PG8_SA(1, 0), a3, voffA);
            PG8_WAIT_V(8); PG8_WAIT_L(0); PG8_BAR; PG8_MMA(1, 0, At, B0); PG8_MMA(1, 1, At, B1); PG8_BAR; PG8_SCHED;
            } else {
            PG8_LDB(B0, 0, 0); PG8_SCHED; PG8_LDA(At, 0, 0); PG8_STAGE(PG8_SA(1, 1), a1 + hstep, voffA);
            PG8_WAIT_L(8); PG8_BAR; PG8_WAIT_L(0); PG8_MMA(0, 0, At, B0); PG8_BAR; PG8_SCHED;
            PG8_LDB(B1, 0, 1); PG8_STAGE(PG8_SB(0, 0), b2, voffB);
            PG8_BAR; PG8_WAIT_L(0); PG8_MMA(0, 1, At, B1); PG8_BAR;
            PG8_LDA(At, 0, 1); PG8_STAGE(PG8_SA(0, 0), a2, voffA);
            PG8_BAR; PG8_WAIT_L(0); PG8_MMA(1, 0, At, B0); PG8_BAR; PG8_SCHED;
            PG8_STAGE(PG8_SB(0, 1), b2 + hstep, voffB);
            PG8_WAIT_V(6); PG8_BAR; PG8_MMA(1, 1, At, B1); PG8_BAR;
            PG8_LDB(B0, 1, 0); PG8_SCHED; PG8_LDA(At, 1, 0); PG8_STAGE(PG8_SA(0, 1), a2 + hstep, voffA);
            PG8_WAIT_L(8); PG8_BAR; PG8_WAIT_L(0); PG8_MMA(0, 0, At, B0); PG8_BAR; PG8_SCHED;
            PG8_LDB(B1, 1, 1); PG8_STAGE(PG8_SB(1, 0), b3, voffB);
            PG8_BAR; PG8_WAIT_L(0); PG8_MMA(0, 1, At, B1); PG8_BAR;
            PG8_LDA(At, 1, 1); PG8_STAGE(PG8_SA(1, 0), a3, voffA);
            PG8_BAR; PG8_WAIT_L(0); PG8_MMA(1, 0, At, B0); PG8_BAR; PG8_SCHED;
            PG8_STAGE(PG8_SB(1, 1), b3 + hstep, voffB);
            PG8_WAIT_V(6); PG8_BAR; PG8_MMA(1, 1, At, B1); PG8_BAR;
            }
        }
        if constexpr (ALIGN_EPI) { if (wr == 0) PG8_BAR; }
        if constexpr (!Epi::AFTER_DRAIN) { E(acc, cur, wr, wc, fr, fq); S.done(cur); }
        if (!has_next) break;
#pragma unroll
        for (int a = 0; a < 2; ++a)
#pragma unroll
            for (int b = 0; b < 2; ++b)
#pragma unroll
                for (int m = 0; m < 4; ++m)
#pragma unroll
                    for (int n = 0; n < 2; ++n) acc[a][b][m][n] = (f32x4){0.f, 0.f, 0.f, 0.f};
        cur = nxt; cA = nA; cB = nB; ++ui;
        if constexpr (ALIGN_EPI) { if (wr == 1) PG8_BAR; }
    }
    PG8_WAIT_V(0);
    if constexpr (!ALIGN_EPI) { if (wr == 0) PG8_BAR; }
    PG8_BAR;
    if constexpr (Epi::AFTER_DRAIN) { E.fused(acc, cur, wr, wc, fr, fq, lds, wid, lane); S.done(cur); }
#undef PG8_SA
#undef PG8_SB
#undef PG8_STAGE
#undef PG8_LDA
#undef PG8_LDB
#undef PG8_MMA
#undef PG8_WAIT_V
#undef PG8_WAIT_L
#undef PG8_BAR
#undef PG8_SCHED
}
}

#define LAS __attribute__((address_space(3)))
using pg8::bf16_t; using pg8::bf16x8; using pg8::f32x4; using pg8::u32x4; using pg8::cvt_pk_bf16;
constexpr int D = 1024, NBATCH = 8, SEQ = 2048, CTXL = 256;
constexpr int ML = NBATCH * SEQ, MC = NBATCH * CTXL, MT = ML + MC;
constexpr int DIN = 2560, DFF = 4096, DL = 512, NMOD = 6144;
constexpr int NCHUNK = MT / 64;
constexpr int NTHREADS = 512;
constexpr int LDS_BYTES = 147456;

constexpr size_t MiB = 1u << 20;
constexpr size_t WS_MOD = 0;
constexpr size_t WS_BIN = WS_MOD + 2 * 9 * 6144 * 4;
constexpr size_t WS_B1  = WS_BIN + 2 * 9 * 2560 * 4;
constexpr size_t WS_LC  = WS_B1 + 2 * 9 * 4096 * 4;
constexpr size_t WS_WG  = WS_LC + 2 * 512 * 8 * 4;
constexpr size_t WS_CS  = WS_WG + 2 * 8 * 4 * 64 * 64 * 2;
constexpr size_t WS_SSQ = WS_CS + (size_t)NCHUNK * 2 * 2 * 512 * 4;
constexpr size_t WS_YSL = WS_SSQ + (size_t)MT * 16 * 4;
constexpr size_t WS_YSC = WS_YSL + (size_t)MT * 8 * 4;
constexpr size_t WS_SMALL_END = WS_YSC + (size_t)MT * 4;
static_assert(WS_SMALL_END <= 8 * MiB, "small tables");
constexpr size_t WS_W = 8 * MiB;
constexpr size_t W_LAYER = 23 * MiB, W_IN = 0, W_OUT = 5 * MiB, W_1 = 7 * MiB, W_2 = 15 * MiB;
constexpr size_t WS_XC = 54 * MiB;
constexpr size_t WS_XS = 62 * MiB;
constexpr size_t WS_H = 98 * MiB;
constexpr size_t WS_U = 98 * MiB;
constexpr size_t WS_Y = 188 * MiB;
constexpr size_t WS_END = 242 * MiB;

struct Args { const float* in[23]; float* out; unsigned char* ws; };
enum { I_X = 0, I_C, I_CTX, I_CCTX, I_ADAW, I_ADAB, I_N1G, I_N2G, I_WIN, I_C4W, I_C4B, I_GAW, I_GAB, I_GXW, I_GXB, I_LAM, I_C3W, I_GOL, I_GOC, I_WOUT, I_W1, I_W2, I_FING };

__device__ __forceinline__ float wave_sum(float v) {
#pragma unroll
    for (int o = 1; o < 64; o <<= 1) v += __shfl_xor(v, o);
    return v;
}
__device__ __forceinline__ float sigmoid_f(float x) { return __builtin_amdgcn_rcpf(1.0f + __builtin_amdgcn_exp2f(-1.44269504089f * x)); }
__device__ __forceinline__ float gelu_tanh(float x) { const float z = 0.7978845608f * (x + 0.044715f * x * x * x); return x * sigmoid_f(2.0f * z); }
__device__ __forceinline__ void unpack8(const u32x4 w, float (&f)[8]) {
    f[0] = __uint_as_float(w.x << 16); f[1] = __uint_as_float(w.x & 0xffff0000u); f[2] = __uint_as_float(w.y << 16); f[3] = __uint_as_float(w.y & 0xffff0000u);
    f[4] = __uint_as_float(w.z << 16); f[5] = __uint_as_float(w.z & 0xffff0000u); f[6] = __uint_as_float(w.w << 16); f[7] = __uint_as_float(w.w & 0xffff0000u);
}
__device__ __forceinline__ u32x4 pack8(const float (&f)[8]) { u32x4 w; w.x = cvt_pk_bf16(f[0], f[1]); w.y = cvt_pk_bf16(f[2], f[3]); w.z = cvt_pk_bf16(f[4], f[5]); w.w = cvt_pk_bf16(f[6], f[7]); return w; }

__device__ __forceinline__ void transpose_item(const float* W, int K, int N, bf16_t* WT, const float* ks, LAS float* scr, int item, int lane) {
    const int nblk = N / 32, kb = item / nblk, nb = item % nblk, k0 = 64 * kb, n0 = 32 * nb;
#pragma unroll 8
    for (int i = 0; i < 32; ++i) { const int kk = 2 * i + (lane >> 5); float v = W[(size_t)(k0 + kk) * N + n0 + (lane & 31)]; if (ks) v *= ks[k0 + kk]; scr[kk * 33 + (lane & 31)] = v; }
    asm volatile("s_waitcnt lgkmcnt(0)" ::: "memory");
    const int c = lane & 7;
#pragma unroll
    for (int j = 0; j < 4; ++j) { const int n = (lane >> 3) + 8 * j; const LAS float* s = scr + (8 * c) * 33 + n;
        u32x4 o; o.x = cvt_pk_bf16(s[0 * 33], s[1 * 33]); o.y = cvt_pk_bf16(s[2 * 33], s[3 * 33]); o.z = cvt_pk_bf16(s[4 * 33], s[5 * 33]); o.w = cvt_pk_bf16(s[6 * 33], s[7 * 33]);
        *(u32x4*)(WT + (size_t)(n0 + n) * K + k0 + 8 * c) = o; }
    asm volatile("s_waitcnt lgkmcnt(0)" ::: "memory");
}

__device__ __forceinline__ void gemv9_item(LAS float* Sx, LAS float* red, const float* W, int N, int n0, float* out, const float* addb, int tid) {
    const int lane = tid & 63, wid = tid >> 6;
    float acc[9];
#pragma unroll
    for (int b = 0; b < 9; ++b) acc[b] = 0.f;
    const float* wp = W + (size_t)(wid * 128) * N + n0 + lane;
#pragma unroll 8
    for (int k = 0; k < 128; ++k) {
        const float wv = wp[(size_t)k * N];
        const LAS float* s = Sx + (wid * 128 + k) * 12;
        const f32x4 s0 = *(const LAS f32x4*)s, s1 = *(const LAS f32x4*)(s + 4); const float s8 = s[8];
        acc[0] += s0[0] * wv; acc[1] += s0[1] * wv; acc[2] += s0[2] * wv; acc[3] += s0[3] * wv;
        acc[4] += s1[0] * wv; acc[5] += s1[1] * wv; acc[6] += s1[2] * wv; acc[7] += s1[3] * wv; acc[8] += s8 * wv;
    }
#pragma unroll
    for (int b = 0; b < 9; ++b) red[(wid * 9 + b) * 64 + lane] = acc[b];
    __syncthreads();
    for (int idx = tid; idx < 576; idx += NTHREADS) {
        const int b = idx >> 6, ln = idx & 63; float s = 0.f;
#pragma unroll
        for (int w = 0; w < 8; ++w) s += red[(w * 9 + b) * 64 + ln];
        out[(size_t)b * N + n0 + ln] = s + (addb ? addb[n0 + ln] : 0.f);
    }
    __syncthreads();
}

struct MixP { const bf16_t* U; bf16_t* Y; float* CS; float* YSL; float* YSC; const bf16_t* WG; const float* LC; const float* c4w; const float* c4b; const float* c3w; };

template <bool APPLY>
__device__ __forceinline__ void lru_unit(LAS unsigned char* lds, const MixP& P, int cgi, int h, int tid) {
    const int lane = tid & 63, wid = tid >> 6;
    LAS bf16_t* Vb = (LAS bf16_t*)lds;
    LAS float* Vf = (LAS float*)(lds + 9216);
    LAS float* AF = Vf + 64 * 68; LAS float* BF = AF + 64 * 68; LAS float* AR = BF + 64 * 68; LAS float* BR = AR + 64 * 68;
    const bool is_ctx = cgi >= 256;
    const int row0 = cgi * 64;
    const int bidx = is_ctx ? ((cgi - 256) >> 2) : (cgi >> 5);
    const int j = is_ctx ? ((cgi - 256) & 3) : (cgi & 31);
    const int tseq0 = j * 64, slen = is_ctx ? CTXL : SEQ;
    {
        const int t = tid >> 3, c8 = (tid & 7) * 8, ch = h * 64 + c8;
        float v[8];
        { const f32x4 b0 = *(const f32x4*)(P.c4b + ch), b1 = *(const f32x4*)(P.c4b + ch + 4); v[0] = b0[0]; v[1] = b0[1]; v[2] = b0[2]; v[3] = b0[3]; v[4] = b1[0]; v[5] = b1[1]; v[6] = b1[2]; v[7] = b1[3]; }
#pragma unroll
        for (int k = 0; k < 4; ++k) {
            const int ts = tseq0 + t + k - 1;
            if (ts >= 0 && ts < slen) {
                const u32x4 w = *(const u32x4*)(P.U + (size_t)(row0 + t + k - 1) * DIN + ch);
                float uf[8]; unpack8(w, uf);
                const f32x4 w0 = *(const f32x4*)(P.c4w + k * DL + ch), w1 = *(const f32x4*)(P.c4w + k * DL + ch + 4);
                v[0] += w0[0] * uf[0]; v[1] += w0[1] * uf[1]; v[2] += w0[2] * uf[2]; v[3] += w0[3] * uf[3];
                v[4] += w1[0] * uf[4]; v[5] += w1[1] * uf[5]; v[6] += w1[2] * uf[6]; v[7] += w1[3] * uf[7];
            }
        }
        *(LAS u32x4*)(Vb + t * 72 + c8) = pack8(v);
        *(LAS f32x4*)(Vf + t * 68 + c8) = (f32x4){v[0], v[1], v[2], v[3]};
        *(LAS f32x4*)(Vf + t * 68 + c8 + 4) = (f32x4){v[4], v[5], v[6], v[7]};
    }
    float carry = 0.f;
    if (APPLY && wid < 2) {
        const int dir = wid;
        const float* cs = P.CS + (size_t)dir * 1024 + h * 64 + lane;
        const int cbase = 256 + 4 * bidx, sbase = is_ctx ? cbase : 32 * bidx, sn = is_ctx ? 4 : 32;
        if (dir == 0) {
            if (!is_ctx) for (int c = 0; c < 4; ++c) { const float* p = cs + (size_t)(cbase + c) * 2048; carry = p[0] * carry + p[512]; }
            for (int c = 0; c < j; ++c) { const float* p = cs + (size_t)(sbase + c) * 2048; carry = p[0] * carry + p[512]; }
        } else {
            if (!is_ctx) for (int c = 3; c >= 0; --c) { const float* p = cs + (size_t)(cbase + c) * 2048; carry = p[0] * carry + p[512]; }
            for (int c = sn - 1; c > j; --c) { const float* p = cs + (size_t)(sbase + c) * 2048; carry = p[0] * carry + p[512]; }
        }
    }
    __syncthreads();
    {
        const int fr = lane & 15, fq = lane >> 4, mt = wid >> 1;
        bf16x8 vfrag[2];
#pragma unroll
        for (int ks = 0; ks < 2; ++ks) vfrag[ks] = *(const LAS bf16x8*)(Vb + (16 * mt + fr) * 72 + ks * 32 + fq * 8);
        const bf16_t* wg = P.WG + (size_t)h * 4 * 4096;
        const int t = 16 * mt + fr;
#pragma unroll
        for (int cqi = 0; cqi < 2; ++cqi) {
            const int cq = 2 * (wid & 1) + cqi;
            f32x4 acc[4];
#pragma unroll
            for (int g = 0; g < 4; ++g) {
                acc[g] = (f32x4){0.f, 0.f, 0.f, 0.f};
#pragma unroll
                for (int ks = 0; ks < 2; ++ks) {
                    const bf16x8 wf = *(const bf16x8*)(wg + g * 4096 + (16 * cq + fr) * 64 + ks * 32 + fq * 8);
                    acc[g] = __builtin_amdgcn_mfma_f32_16x16x32_bf16(wf, vfrag[ks], acc[g], 0, 0, 0);
                }
            }
            const int c0 = 16 * cq + 4 * fq;
            const f32x4 vv = *(const LAS f32x4*)(Vf + t * 68 + c0);
            f32x4 af, bf, ar, br;
#pragma unroll
            for (int r = 0; r < 4; ++r) {
                const float* lc = P.LC + (size_t)(h * 64 + c0 + r) * 8;
                const f32x4 l0 = *(const f32x4*)lc, l1 = *(const f32x4*)(lc + 4);
                { const float rr = sigmoid_f(acc[0][r] + l0[0]), ii = sigmoid_f(acc[1][r] + l0[1]); const float a = __builtin_amdgcn_exp2f(-l0[2] * rr);
                  af[r] = a; bf[r] = __builtin_amdgcn_sqrtf(fmaxf(1.0f - a * a, 0.f)) * (ii * vv[r]); }
                { const float rr = sigmoid_f(acc[2][r] + l0[3]), ii = sigmoid_f(acc[3][r] + l1[0]); const float a = __builtin_amdgcn_exp2f(-l1[1] * rr);
                  ar[r] = a; br[r] = __builtin_amdgcn_sqrtf(fmaxf(1.0f - a * a, 0.f)) * (ii * vv[r]); }
            }
            *(LAS f32x4*)(AF + t * 68 + c0) = af; *(LAS f32x4*)(BF + t * 68 + c0) = bf; *(LAS f32x4*)(AR + t * 68 + c0) = ar; *(LAS f32x4*)(BR + t * 68 + c0) = br;
        }
    }
    __syncthreads();
    if (wid < 2) {
        const int dir = wid;
        LAS float* Aa = dir ? AR : AF; LAS float* Bb = dir ? BR : BF;
        float hst = carry, pp = 1.f;
#pragma unroll 8
        for (int s = 0; s < 64; ++s) {
            const int t = dir ? 63 - s : s;
            const float a = Aa[t * 68 + lane], b = Bb[t * 68 + lane];
            hst = a * hst + b;
            if (APPLY) Bb[t * 68 + lane] = hst; else pp *= a;
        }
        if (!APPLY) { float* cs = P.CS + (size_t)cgi * 2048 + dir * 1024 + h * 64 + lane; cs[0] = pp; cs[512] = hst; }
    }
    if (APPLY) {
        __syncthreads();
        const int t = tid >> 3, c8 = (tid & 7) * 8, row = row0 + t;
        const u32x4 gw = *(const u32x4*)(P.U + (size_t)row * DIN + DL + h * 64 + c8);
        float gf[8]; unpack8(gw, gf);
        const f32x4 f0 = *(const LAS f32x4*)(BF + t * 68 + c8), f1 = *(const LAS f32x4*)(BF + t * 68 + c8 + 4);
        const f32x4 r0 = *(const LAS f32x4*)(BR + t * 68 + c8), r1 = *(const LAS f32x4*)(BR + t * 68 + c8 + 4);
        float y[8]; float ss = 0.f;
#pragma unroll
        for (int q = 0; q < 4; ++q) { y[q] = gelu_tanh(gf[q]) * (f0[q] + r0[q]); y[q + 4] = gelu_tanh(gf[q + 4]) * (f1[q] + r1[q]); }
#pragma unroll
        for (int q = 0; q < 8; ++q) ss += y[q] * y[q];
        *(u32x4*)(P.Y + (size_t)row * D + h * 64 + c8) = pack8(y);
        ss += __shfl_xor(ss, 1); ss += __shfl_xor(ss, 2); ss += __shfl_xor(ss, 4);
        if ((tid & 7) == 0) P.YSL[(size_t)row * 8 + h] = ss;
    }
    __syncthreads();
}

__device__ __forceinline__ void conv_unit(const MixP& P, int cgi, int tid) {
    const bool is_ctx = cgi >= 256;
    const int tok = tid >> 3, sub = tid & 7, row = cgi * 64 + tok;
    const int tseq = (is_ctx ? ((cgi - 256) & 3) : (cgi & 31)) * 64 + tok;
    const bf16_t* ur = P.U + (size_t)row * DIN;
    float ss = 0.f;
#pragma unroll 2
    for (int q = 0; q < 8; ++q) {
        const int ch = q * 64 + sub * 8;
        int d; bool vm, vp;
        if (is_ctx) { d = 1; vm = tseq >= 1; vp = tseq + 1 < CTXL; }
        else if (q < 4) { d = 1; vm = tok >= 1; vp = tok < 63; }
        else { d = 64; vm = tseq >= 64; vp = tseq + 64 < SEQ; }
        float acc[8], xa[8], ca[8];
        { unpack8(*(const u32x4*)(ur + 1024 + ch), xa); unpack8(*(const u32x4*)(ur + 2048 + ch), ca);
          const f32x4 w0 = *(const f32x4*)(P.c3w + DL + ch), w1 = *(const f32x4*)(P.c3w + DL + ch + 4);
#pragma unroll
          for (int i = 0; i < 4; ++i) { acc[i] = w0[i] * (xa[i] * ca[i]); acc[i + 4] = w1[i] * (xa[i + 4] * ca[i + 4]); } }
        if (vm) { const bf16_t* un = ur - (size_t)d * DIN; unpack8(*(const u32x4*)(un + 1024 + ch), xa); unpack8(*(const u32x4*)(un + 2048 + ch), ca);
          const f32x4 w0 = *(const f32x4*)(P.c3w + ch), w1 = *(const f32x4*)(P.c3w + ch + 4);
#pragma unroll
          for (int i = 0; i < 4; ++i) { acc[i] += w0[i] * (xa[i] * ca[i]); acc[i + 4] += w1[i] * (xa[i + 4] * ca[i + 4]); } }
        if (vp) { const bf16_t* un = ur + (size_t)d * DIN; unpack8(*(const u32x4*)(un + 1024 + ch), xa); unpack8(*(const u32x4*)(un + 2048 + ch), ca);
          const f32x4 w0 = *(const f32x4*)(P.c3w + 2 * DL + ch), w1 = *(const f32x4*)(P.c3w + 2 * DL + ch + 4);
#pragma unroll
          for (int i = 0; i < 4; ++i) { acc[i] += w0[i] * (xa[i] * ca[i]); acc[i + 4] += w1[i] * (xa[i + 4] * ca[i + 4]); } }
        float bg[8]; unpack8(*(const u32x4*)(ur + 1536 + ch), bg);
#pragma unroll
        for (int i = 0; i < 8; ++i) { acc[i] *= bg[i]; ss += acc[i] * acc[i]; }
        *(u32x4*)(P.Y + (size_t)row * D + DL + ch) = pack8(acc);
    }
    ss += __shfl_xor(ss, 1); ss += __shfl_xor(ss, 2); ss += __shfl_xor(ss, 4);
    if (sub == 0) P.YSC[row] = ss;
}

__global__ void __launch_bounds__(NTHREADS, 2) fwd_megakernel(Args args) {
    extern __shared__ __attribute__((aligned(16))) unsigned char lds_raw[];
    LAS unsigned char* lds = (LAS unsigned char*)lds_raw;
    const int tid = threadIdx.x, lane = tid & 63, wid = __builtin_amdgcn_readfirstlane(tid >> 6);
    const int G = gridDim.x, bx = blockIdx.x;
    unsigned char* ws = args.ws;
    float* MOD = (float*)(ws + WS_MOD); float* BIN = (float*)(ws + WS_BIN); float* B1 = (float*)(ws + WS_B1); float* LC = (float*)(ws + WS_LC);
    bf16_t* WG = (bf16_t*)(ws + WS_WG); float* CS = (float*)(ws + WS_CS); float* SSQ = (float*)(ws + WS_SSQ); float* YSL = (float*)(ws + WS_YSL); float* YSC = (float*)(ws + WS_YSC);
    float* XC = (float*)(ws + WS_XC); bf16_t* XS = (bf16_t*)(ws + WS_XS); bf16_t* HB = (bf16_t*)(ws + WS_H); bf16_t* U = (bf16_t*)(ws + WS_U); bf16_t* Y = (bf16_t*)(ws + WS_Y);
    const int gw = bx * 8 + wid, NGW = G * 8;

    {
        LAS float* Sx = (LAS float*)lds; LAS float* red = (LAS float*)(lds + 49152);
        bool loaded = false;
        for (int it = bx; it < 2 * (NMOD / 64); it += G) {
            if (!loaded) {
                for (int idx = tid; idx < 9 * 1024; idx += NTHREADS) { const int b = idx >> 10, k = idx & 1023; const float c = b < 8 ? args.in[I_C][b * 1024 + k] : args.in[I_CCTX][k]; Sx[k * 12 + b] = c * sigmoid_f(c); }
                __syncthreads(); loaded = true;
            }
            const int l = it / (NMOD / 64), n0 = (it % (NMOD / 64)) * 64;
            gemv9_item(Sx, red, args.in[I_ADAW] + (size_t)l * D * NMOD, NMOD, n0, MOD + (size_t)l * 9 * NMOD, args.in[I_ADAB] + (size_t)l * NMOD, tid);
        }
        __syncthreads();
        LAS float* scr = (LAS float*)(lds + wid * 16384);
        constexpr int T_IN = (D / 64) * (DIN / 32), T_OUT = (D / 64) * (D / 32), T_1 = (D / 64) * (DFF / 32), T_2 = (DFF / 64) * (D / 32), T_L = T_IN + T_OUT + T_1 + T_2;
        for (int it = gw; it < 2 * T_L; it += NGW) {
            const int l = it / T_L; int r = it % T_L;
            bf16_t* wl = (bf16_t*)(ws + WS_W + (size_t)l * W_LAYER);
            if (r < T_IN) { transpose_item(args.in[I_WIN] + (size_t)l * D * DIN, D, DIN, (bf16_t*)((unsigned char*)wl + W_IN), nullptr, scr, r, lane); continue; } r -= T_IN;
            if (r < T_OUT) {
                const int kb = r / (D / 32); const float* ks = kb < 8 ? args.in[I_GOL] + (size_t)l * DL : args.in[I_GOC] + (size_t)l * DL - DL;
                transpose_item(args.in[I_WOUT] + (size_t)l * D * D, D, D, (bf16_t*)((unsigned char*)wl + W_OUT), ks, scr, r, lane); continue; } r -= T_OUT;
            if (r < T_1) { transpose_item(args.in[I_W1] + (size_t)l * D * DFF, D, DFF, (bf16_t*)((unsigned char*)wl + W_1), nullptr, scr, r, lane); continue; } r -= T_1;
            transpose_item(args.in[I_W2] + (size_t)l * DFF * D, DFF, D, (bf16_t*)((unsigned char*)wl + W_2), nullptr, scr, r, lane);
        }
        for (int idx = bx * NTHREADS + tid; idx < 2 * 8 * 4 * 64 * 64; idx += G * NTHREADS) {
            const int d = idx & 63, e = (idx >> 6) & 63, g = (idx >> 12) & 3, h = (idx >> 14) & 7, l = idx >> 17;
            const float* src = (g & 1) ? args.in[I_GXW] : args.in[I_GAW];
            const float v = src[((size_t)((l * 2 + (g >> 1)) * 8 + h) * 64 + d) * 64 + e];
            WG[idx] = (bf16_t)(cvt_pk_bf16(v, 0.f) & 0xffffu);
        }
        for (int idx = bx * NTHREADS + tid; idx < 2 * DL; idx += G * NTHREADS) {
            const int l = idx / DL, ch = idx % DL; float* lc = LC + (size_t)idx * 8;
            const float lf = args.in[I_LAM][(l * 2 + 0) * DL + ch], lr = args.in[I_LAM][(l * 2 + 1) * DL + ch];
            lc[0] = args.in[I_GAB][(l * 2 + 0) * DL + ch]; lc[1] = args.in[I_GXB][(l * 2 + 0) * DL + ch]; lc[2] = 8.0f * log1pf(expf(-lf)) * 1.44269504089f;
            lc[3] = args.in[I_GAB][(l * 2 + 1) * DL + ch]; lc[4] = args.in[I_GXB][(l * 2 + 1) * DL + ch]; lc[5] = 8.0f * log1pf(expf(-lr)) * 1.44269504089f;
            lc[6] = 0.f; lc[7] = 0.f;
        }
    }
    cg::this_grid().sync();
    {
        LAS float* Sx = (LAS float*)lds; LAS float* red = (LAS float*)(lds + 49152);
        constexpr int NI_IN = DIN / 64, NI_1 = DFF / 64, NI_L = NI_IN + NI_1;
        for (int it = bx; it < 2 * NI_L; it += G) {
            const int l = it / NI_L, r = it % NI_L; const bool is1 = r >= NI_IN;
            const float* sh = MOD + (size_t)l * 9 * NMOD + (is1 ? 3 * D : 0);
            __syncthreads();
            for (int idx = tid; idx < 9 * 1024; idx += NTHREADS) { const int b = idx >> 10, k = idx & 1023; Sx[k * 12 + b] = sh[(size_t)b * NMOD + k]; }
            __syncthreads();
            if (!is1) gemv9_item(Sx, red, args.in[I_WIN] + (size_t)l * D * DIN, DIN, r * 64, BIN + (size_t)l * 9 * DIN, nullptr, tid);
            else gemv9_item(Sx, red, args.in[I_W1] + (size_t)l * D * DFF, DFF, (r - NI_IN) * 64, B1 + (size_t)l * 9 * DFF, nullptr, tid);
        }
        for (int m = gw; m < MT; m += NGW) {
            const bool lat = m < ML; const int b = lat ? m / SEQ : 8;
            const float* xr = lat ? args.in[I_X] + (size_t)m * D : args.in[I_CTX] + (size_t)(m - ML) * D;
            const float* sc = MOD + (size_t)b * NMOD + D; const float* ng = args.in[I_N1G];
            float s = 0.f;
#pragma unroll
            for (int q = 0; q < 4; ++q) {
                const int c = q * 256 + lane * 4;
                const f32x4 v = *(const f32x4*)(xr + c), g = *(const f32x4*)(ng + c), sv = *(const f32x4*)(sc + c);
                s += (v[0] * v[0] + v[1] * v[1]) + (v[2] * v[2] + v[3] * v[3]);
                const f32x4 z = v * (g * (sv + 1.0f));
                unsigned long long o = (unsigned long long)cvt_pk_bf16(z[0], z[1]) | ((unsigned long long)cvt_pk_bf16(z[2], z[3]) << 32);
                *(unsigned long long*)(XS + (size_t)m * D + c) = o;
            }
            s = wave_sum(s);
            if (lane < 16) SSQ[(size_t)m * 16 + lane] = lane == 0 ? s : 0.f;
        }
    }
    cg::this_grid().sync();

#pragma nounroll
    for (int l = 0; l < 2; ++l) {
        const bool lastl = (l == 1);
        const float* modl = MOD + (size_t)l * 9 * NMOD;
        const unsigned char* wl = ws + WS_W + (size_t)l * W_LAYER;
        const int nMall = lastl ? 64 : 72;
        {
            pg8::Gemm g{XS, (const bf16_t*)(wl + W_IN), MT, DIN, D};
            pg8::Order S; S.init(nMall, DIN / 256, G, bx, 64, lastl ? 16 : 0);
            pg8::EpiLin<0> E{U, DIN, BIN + (size_t)l * 9 * DIN, DIN, SSQ};
            pg8::gemm_phase<pg8::EpiLin<0>, pg8::Order, true, true>(lds, g, S, E);
        }
        cg::this_grid().sync();
        MixP P{U, Y, CS, YSL, YSC, WG + (size_t)l * 8 * 4 * 4096, LC + (size_t)l * DL * 8, args.in[I_C4W] + (size_t)l * 4 * DL, args.in[I_C4B] + (size_t)l * DL, args.in[I_C3W] + (size_t)l * 3 * DL};
        {
            const int n_lru = NCHUNK * 8, n_conv = lastl ? 256 : NCHUNK;
            int mtid = threadIdx.x; asm volatile("" : "+v"(mtid));
            for (int it = bx; it < n_lru + n_conv; it += G) {
                if (it < n_lru) lru_unit<false>(lds, P, it >> 3, it & 7, mtid);
                else conv_unit(P, it - n_lru, mtid);
            }
        }
        cg::this_grid().sync();
        {
            const int n_lru = (lastl ? 256 : NCHUNK) * 8;
            int mtid = threadIdx.x; asm volatile("" : "+v"(mtid));
            for (int it = bx; it < n_lru; it += G) lru_unit<true>(lds, P, it >> 3, it & 7, mtid);
        }
        cg::this_grid().sync();
        {
            pg8::Gemm g{Y, (const bf16_t*)(wl + W_OUT), MT, D, D};
            pg8::Order S; S.init(nMall, D / 256, G, bx, 0, 0);
            pg8::EpiRes<true> E{l == 0 ? args.in[I_X] : args.out, l == 0 ? args.in[I_CTX] : XC, args.out, XC, modl + 2 * D, modl + 4 * D, args.in[I_N2G] + (size_t)l * D, XS, SSQ, YSL, YSC};
            pg8::gemm_phase<pg8::EpiRes<true>, pg8::Order, true, true>(lds, g, S, E);
        }
        cg::this_grid().sync();
        {
            pg8::Gemm g{XS, (const bf16_t*)(wl + W_1), MT, DFF, D};
            pg8::Order S; S.init(nMall, DFF / 256, G, bx, 0, 0);
            pg8::EpiLin<1> E{HB, DFF, B1 + (size_t)l * 9 * DFF, DFF, SSQ};
            pg8::gemm_phase<pg8::EpiLin<1>, pg8::Order, true, true>(lds, g, S, E);
        }
        cg::this_grid().sync();
        {
            pg8::Gemm g{HB, (const bf16_t*)(wl + W_2), MT, D, DFF};
            pg8::Order S; S.init(nMall, D / 256, G, bx, 0, 0);
            const float* nsc = lastl ? nullptr : (MOD + (size_t)(l + 1) * 9 * NMOD + D);
            pg8::EpiRes<false> E{args.out, XC, args.out, XC, modl + 5 * D, nsc, args.in[I_N1G] + (size_t)(lastl ? 0 : (l + 1)) * D, XS, SSQ, YSL, YSC};
            pg8::gemm_phase<pg8::EpiRes<false>, pg8::Order, true, true>(lds, g, S, E);
        }
        cg::this_grid().sync();
    }
    int flane = lane; asm volatile("" : "+v"(flane));
    for (int m = gw; m < ML; m += NGW) {
        const f32x4 a = *(const f32x4*)(SSQ + (size_t)m * 16), b = *(const f32x4*)(SSQ + (size_t)m * 16 + 4), c = *(const f32x4*)(SSQ + (size_t)m * 16 + 8), d = *(const f32x4*)(SSQ + (size_t)m * 16 + 12);
        const float s = (((a[0] + a[1]) + (a[2] + a[3])) + ((b[0] + b[1]) + (b[2] + b[3]))) + (((c[0] + c[1]) + (c[2] + c[3])) + ((d[0] + d[1]) + (d[2] + d[3])));
        const float rs = 1.0f / sqrtf(s * (1.0f / 1024.0f) + pg8::RMS_EPS);
        float* xr = args.out + (size_t)m * D;
#pragma unroll
        for (int q = 0; q < 4; ++q) { const int cc = q * 256 + flane * 4; const f32x4 v = *(const f32x4*)(xr + cc), g = *(const f32x4*)(args.in[I_FING] + cc); *(f32x4*)(xr + cc) = v * rs * g; }
    }
}

extern "C" void kernel_launch(void* const* d_in, const int* in_sizes, int n_in, void* d_out, int out_size, void* d_ws, size_t ws_size, hipStream_t stream) {
    static int grid_blocks = 0;
    if (grid_blocks == 0) {
        if (n_in != 23 || out_size != ML * D || ws_size < WS_END) { fprintf(stderr, "kernel_launch: unexpected problem (n_in %d out %d ws %zu)\n", n_in, out_size, ws_size); grid_blocks = -1; return; }
        int dev = 0, cus = 0, per_cu = 0;
        hipGetDevice(&dev);
        hipDeviceGetAttribute(&cus, hipDeviceAttributeMultiprocessorCount, dev);
        if (hipFuncSetAttribute((const void*)fwd_megakernel, hipFuncAttributeMaxDynamicSharedMemorySize, LDS_BYTES) != hipSuccess) { fprintf(stderr, "kernel_launch: hipFuncSetAttribute failed\n"); grid_blocks = -1; return; }
        if (hipOccupancyMaxActiveBlocksPerMultiprocessor(&per_cu, (const void*)fwd_megakernel, NTHREADS, LDS_BYTES) != hipSuccess || per_cu < 1) { fprintf(stderr, "kernel_launch: occupancy query failed (%d)\n", per_cu); per_cu = 1; }
        (void)hipGetLastError();
        grid_blocks = cus * 1;
        fprintf(stderr, "kernel_launch: cus %d per_cu %d grid %d\n", cus, per_cu, grid_blocks);
    }
    if (grid_blocks < 0) return;
    Args a{};
    for (int i = 0; i < 23; ++i) a.in[i] = (const float*)d_in[i];
    a.out = (float*)d_out; a.ws = (unsigned char*)d_ws;
    void* kargs[] = {&a};
    hipError_t e = hipLaunchCooperativeKernel((const void*)fwd_megakernel, dim3(grid_blocks), dim3(NTHREADS), kargs, LDS_BYTES, stream);
    if (e != hipSuccess) fprintf(stderr, "kernel_launch: cooperative launch failed: %s (grid %d)\n", hipGetErrorString(e), grid_blocks);
}
```

```cpp
#include <hip/hip_runtime.h>
#include <hip/hip_cooperative_groups.h>
#include <cstdio>
#include <cstdint>
namespace cg = cooperative_groups;
namespace pg8 {
#define PG8_LAS __attribute__((address_space(3)))
typedef unsigned short bf16_t;
typedef short bf16x8 __attribute__((ext_vector_type(8)));
typedef float f32x4 __attribute__((ext_vector_type(4)));
typedef unsigned u32x4 __attribute__((ext_vector_type(4)));
constexpr int BM = 256, BK = 64, HALF = 128, HTB = HALF * BK * 2  , STAGE_BYTES = 8 * HTB, NXCD = 8, WGM = 8;

__host__ __device__ __forceinline__ int lds_byte(int r, int c) { const int st = (r >> 4) * 2 + (c >> 5), rr = r & 15, cc = c & 31, ob = rr * 64 + cc * 2; return st * 1024 + (ob ^ (((ob >> 9) & 1) << 5)); }
__host__ __device__ __forceinline__ void stage_rc(int b, int& R, int& C) { const int st = b / 1024, sb = b % 1024, swz = sb ^ (((sb >> 9) & 1) << 5); R = (st >> 1) * 16 + swz / 64; C = (st & 1) * 32 + (swz % 64) / 2; }
__host__ __device__ __forceinline__ int perm32(int rho) { const int n = rho >> 4, i = rho & 15; return 8 * (i >> 2) + 4 * n + (i & 3); }

struct Unit { int pm, pn; };
struct Gemm { const bf16_t* A; const bf16_t* Bt; int M, N, K; };

struct StaticOrder {
    int nM, nN, nwg, G, c;
    __host__ __device__ void init(int M, int N, int G_, int c_) { nM = M / BM; nN = N / BM; nwg = nM * nN; G = G_; c = c_; }
    __host__ __device__ bool next(int i, Unit& u) const {
        const long L = (long)i * G + c; if (L >= nwg) return false;
        int wgid = (int)L; { const int q = nwg / NXCD, r = nwg % NXCD, xcd = wgid % NXCD, off = wgid / NXCD; wgid = (xcd < r ? xcd * (q + 1) : r * (q + 1) + (xcd - r) * q) + off; }
        const int nig = WGM * nN, gid = wgid / nig, fm = gid * WGM, gsz = (nM - fm) < WGM ? (nM - fm) : WGM;
        u.pm = fm + ((wgid % nig) % gsz); u.pn = (wgid % nig) / gsz; return true;
    }
    __device__ __forceinline__ void a_ready(const Unit&) const {}
    __device__ __forceinline__ void done(const Unit&) const {}
};

__device__ __forceinline__ unsigned cvt_pk_bf16(float lo, float hi) { unsigned r; asm volatile("v_cvt_pk_bf16_f32 %0, %1, %2" : "=v"(r) : "v"(lo), "v"(hi)); return r; }
typedef float f32x2 __attribute__((ext_vector_type(2)));
struct Order {
    int nM, nN, nwg, G, c, xM0, nX;
    __device__ void init(int nM_, int nN_, int G_, int c_, int xM0_, int nX_) { nM = nM_; nN = nN_; nwg = nM * nN; G = G_; c = c_; xM0 = xM0_; nX = nX_; }
    __device__ bool next(int i, Unit& u) const {
        const long L = (long)i * G + c;
        if (L >= nwg) { const int j = (int)(L - nwg); if (j >= nX) return false; u.pm = xM0 + (j & 7); u.pn = j >> 3; return true; }
        int wgid = (int)L; { const int q = nwg / NXCD, r = nwg % NXCD, xcd = wgid % NXCD, off = wgid / NXCD; wgid = (xcd < r ? xcd * (q + 1) : r * (q + 1) + (xcd - r) * q) + off; }
        const int nig = WGM * nN, gid = wgid / nig, fm = gid * WGM, gsz = (nM - fm) < WGM ? (nM - fm) : WGM;
        u.pm = fm + ((wgid % nig) % gsz); u.pn = (wgid % nig) / gsz; return true;
    }
    __device__ __forceinline__ void a_ready(const Unit&) const {}
    __device__ __forceinline__ void done(const Unit&) const {}
};

constexpr int ROWS_LAT = 16384;
constexpr float RMS_EPS = 1e-6f;

template <int ACT> struct EpiLin {
    static constexpr bool PERM = true, AFTER_DRAIN = false, MIDK = false;
    bf16_t* O; int ldc; const float* bias; int nb; const float* ssq;
    __device__ __forceinline__ void midk(f32x4 (&)[2][2][4][2], const Unit&, int, int, int, int) const {}
    __device__ __forceinline__ void operator()(const f32x4 (&acc)[2][2][4][2], const Unit& u, int wr, int wc, int fr, int fq) const {
        asm volatile("" : "+v"(fr), "+v"(fq));
        const int b = u.pm < 64 ? (u.pm >> 3) : 8;
        const int row0 = u.pm * BM + wr * 64 + fr, col0 = u.pn * BM + wc * 32 + 8 * fq;
        f32x4 bv[2][2];
#pragma unroll
        for (int bj = 0; bj < 2; ++bj)
#pragma unroll
            for (int n = 0; n < 2; ++n) bv[bj][n] = *(const f32x4*)(bias + (size_t)b * nb + col0 + bj * HALF + 4 * n);
#pragma unroll
        for (int ai = 0; ai < 2; ++ai)
#pragma unroll
            for (int m = 0; m < 4; ++m) {
                const int row = row0 + ai * HALF + m * 16;
                const f32x4 p = *(const f32x4*)(ssq + (size_t)row * 16 + 4 * fq);
                float s = (p[0] + p[1]) + (p[2] + p[3]); s += __shfl_xor(s, 16); s += __shfl_xor(s, 32);
                const float rs = __builtin_amdgcn_rsqf(s * (1.0f / 1024.0f) + RMS_EPS);
                bf16_t* rowp = O + (size_t)row * ldc + col0;
#pragma unroll
                for (int bj = 0; bj < 2; ++bj) {
                    f32x4 v0 = acc[ai][bj][m][0] * rs + bv[bj][0], v1 = acc[ai][bj][m][1] * rs + bv[bj][1];
                    if (ACT == 1) {
#pragma unroll
                        for (int j = 0; j < 4; ++j) { const float a = fmaxf(v0[j], 0.f), c = fmaxf(v1[j], 0.f); v0[j] = a * a; v1[j] = c * c; }
                    }
                    u32x4 w; w.x = cvt_pk_bf16(v0[0], v0[1]); w.y = cvt_pk_bf16(v0[2], v0[3]); w.z = cvt_pk_bf16(v1[0], v1[1]); w.w = cvt_pk_bf16(v1[2], v1[3]);
                    *(u32x4*)(rowp + bj * HALF) = w;
                }
                asm volatile("" ::: "memory");
            }
    }
};

template <bool MID> struct EpiRes {
    static constexpr bool PERM = true, AFTER_DRAIN = false, MIDK = MID;
    const float* xin_lat; const float* xin_ctx; float* xout_lat; float* xout_ctx;
    const float* gate;
    const float* nsc;
    const float* ng;
    bf16_t* xs; float* ssq; const float* ysl; const float* ysc;
    __device__ __forceinline__ void midk(f32x4 (&acc)[2][2][4][2], const Unit& u, int wr, int wc, int fr, int fq) const {
        asm volatile("" : "+v"(fr));
        const int row0 = u.pm * BM + wr * 64 + fr;
#pragma unroll
        for (int ai = 0; ai < 2; ++ai)
#pragma unroll
            for (int m = 0; m < 4; ++m) {
                const int row = row0 + ai * HALF + m * 16;
                const f32x4 a = *(const f32x4*)(ysl + (size_t)row * 8), c = *(const f32x4*)(ysl + (size_t)row * 8 + 4);
                const float sl = ((a[0] + a[1]) + (a[2] + a[3])) + ((c[0] + c[1]) + (c[2] + c[3]));
                const float rl = __builtin_amdgcn_rsqf(sl * (1.0f / 512.0f) + RMS_EPS);
                const float qc = ysc[row] * (1.0f / 512.0f) + RMS_EPS;
                const float ratio = rl * __builtin_amdgcn_sqrtf(qc);
#pragma unroll
                for (int bj = 0; bj < 2; ++bj)
#pragma unroll
                    for (int n = 0; n < 2; ++n) acc[ai][bj][m][n] = acc[ai][bj][m][n] * ratio;
                asm volatile("" ::: "memory");
            }
    }
    __device__ __forceinline__ void operator()(const f32x4 (&acc)[2][2][4][2], const Unit& u, int wr, int wc, int fr, int fq) const {
        asm volatile("" : "+v"(fr), "+v"(fq));
        const bool lat = u.pm < 64;
        const int b = lat ? (u.pm >> 3) : 8;
        const int row0 = u.pm * BM + wr * 64 + fr, col0 = u.pn * BM + wc * 32 + 8 * fq;
        const int rbase = lat ? 0 : ROWS_LAT;
        const float* xi = lat ? xin_lat : xin_ctx; float* xo = lat ? xout_lat : xout_ctx;
        f32x4 gv[2][2], nv[2][2];
#pragma unroll
        for (int bj = 0; bj < 2; ++bj)
#pragma unroll
            for (int n = 0; n < 2; ++n) {
                const int c = col0 + bj * HALF + 4 * n;
                gv[bj][n] = *(const f32x4*)(gate + (size_t)b * 6144 + c);
                if (nsc) { const f32x4 s = *(const f32x4*)(nsc + (size_t)b * 6144 + c), g = *(const f32x4*)(ng + c); nv[bj][n] = g * (s + 1.0f); }
                else nv[bj][n] = (f32x4){0.f, 0.f, 0.f, 0.f};
            }
#pragma unroll
        for (int ai = 0; ai < 2; ++ai)
#pragma unroll
            for (int m = 0; m < 4; ++m) {
                const int row = row0 + ai * HALF + m * 16;
                float send = 1.0f;
                if (MID) send = __builtin_amdgcn_rsqf(ysc[row] * (1.0f / 512.0f) + RMS_EPS);
                const size_t off = (size_t)(row - rbase) * 1024 + col0;
                float ss = 0.f;
#pragma unroll
                for (int bj = 0; bj < 2; ++bj) {
                    const f32x4 x0 = *(const f32x4*)(xi + off + bj * HALF), x1 = *(const f32x4*)(xi + off + bj * HALF + 4);
                    const f32x4 y0 = x0 + gv[bj][0] * (acc[ai][bj][m][0] * send), y1 = x1 + gv[bj][1] * (acc[ai][bj][m][1] * send);
                    *(f32x4*)(xo + off + bj * HALF) = y0; *(f32x4*)(xo + off + bj * HALF + 4) = y1;
                    ss += (y0[0] * y0[0] + y0[1] * y0[1]) + (y0[2] * y0[2] + y0[3] * y0[3]);
                    ss += (y1[0] * y1[0] + y1[1] * y1[1]) + (y1[2] * y1[2] + y1[3] * y1[3]);
                    if (nsc) {
                        const f32x4 z0 = y0 * nv[bj][0], z1 = y1 * nv[bj][1];
                        u32x4 w; w.x = cvt_pk_bf16(z0[0], z0[1]); w.y = cvt_pk_bf16(z0[2], z0[3]); w.z = cvt_pk_bf16(z1[0], z1[1]); w.w = cvt_pk_bf16(z1[2], z1[3]);
                        *(u32x4*)(xs + (size_t)row * 1024 + col0 + bj * HALF) = w;
                    }
                }
                ss += __shfl_xor(ss, 16); ss += __shfl_xor(ss, 32);
                if (fq == 0) ssq[(size_t)row * 16 + u.pn * 4 + wc] = ss;
                asm volatile("" ::: "memory");
            }
    }
};

template <class Epi, class Sched, bool ALIGN_EPI = false, bool SP2 = false>
__device__ __forceinline__ void gemm_phase(PG8_LAS unsigned char* lds, const Gemm g, const Sched& S, const Epi& E) {
    int tid_ = threadIdx.x; asm volatile("" : "+v"(tid_));
    const int tid = tid_, wid = __builtin_amdgcn_readfirstlane(tid >> 6), lane = tid & 63, wr = wid >> 2, wc = wid & 3, fr = lane & 15, fq = lane >> 4;
    const int K = g.K, nt = K / BK;
    unsigned voffA[2], voffB[2];
#pragma unroll
    for (int i = 0; i < 2; ++i) { int R, C; stage_rc(tid * 16 + i * 8192, R, C); const int Rb = Epi::PERM ? ((R & ~31) + perm32(R & 31)) : R;
        voffA[i] = (unsigned)(R * K + C) * 2u; voffB[i] = (unsigned)(Rb * K + C) * 2u; }
    const size_t kstep = (size_t)(BK * 2);
    const size_t hstep = (size_t)HALF * K * 2;
    const size_t tstep = 2 * hstep;
    const unsigned ldsw = (unsigned)wid * 1024u;
    const int aoff = lds_byte(wr * 64 + fr, fq * 8), boff = lds_byte(wc * 32 + fr, fq * 8);
#define PG8_SA(b, h) (((b) * 2 + (h)) * HTB)
#define PG8_SB(b, h) ((4 + (b) * 2 + (h)) * HTB)
#define PG8_STAGE(bufoff, gbase, voff) do { _Pragma("unroll") for (int _i = 0; _i < 2; ++_i) \
        __builtin_amdgcn_global_load_lds((const unsigned*)((const char*)(gbase) + (voff)[_i]), (PG8_LAS unsigned*)(lds + (bufoff) + ldsw + _i * 8192), 16, 0, 0); } while (0)
#define PG8_LDA(dst, b, h) do { _Pragma("unroll") for (int m = 0; m < 4; ++m) _Pragma("unroll") for (int k = 0; k < 2; ++k) dst[m][k] = *(const PG8_LAS bf16x8*)(lds + PG8_SA(b, h) + aoff + m * 2048 + k * 1024); } while (0)
#define PG8_LDB(dst, b, h) do { _Pragma("unroll") for (int n = 0; n < 2; ++n) _Pragma("unroll") for (int k = 0; k < 2; ++k) dst[n][k] = *(const PG8_LAS bf16x8*)(lds + PG8_SB(b, h) + boff + n * 2048 + k * 1024); } while (0)
#define PG8_MMA(ai, bj, At, Bt) do { __builtin_amdgcn_s_setprio(1); _Pragma("unroll") for (int m = 0; m < 4; ++m) _Pragma("unroll") for (int n = 0; n < 2; ++n) _Pragma("unroll") for (int k = 0; k < 2; ++k) \
        acc[ai][bj][m][n] = __builtin_amdgcn_mfma_f32_16x16x32_bf16(Bt[n][k], At[m][k], acc[ai][bj][m][n], 0, 0, 0); __builtin_amdgcn_s_setprio(0); } while (0)
#define PG8_WAIT_V(n) asm volatile("s_waitcnt vmcnt(" #n ")" ::: "memory")
#define PG8_WAIT_L(n) asm volatile("s_waitcnt lgkmcnt(" #n ")" ::: "memory")
#define PG8_BAR __builtin_amdgcn_s_barrier()
#define PG8_SCHED __builtin_amdgcn_sched_barrier(0)
    Unit cur, nxt; int ui = 0;
    if (!S.next(0, cur)) return;
    f32x4 acc[2][2][4][2];
#pragma unroll
    for (int a = 0; a < 2; ++a)
#pragma unroll
        for (int b = 0; b < 2; ++b)
#pragma unroll
            for (int m = 0; m < 4; ++m)
#pragma unroll
                for (int n = 0; n < 2; ++n) acc[a][b][m][n] = (f32x4){0.f, 0.f, 0.f, 0.f};
    bf16x8 At[4][2], B0[2][2], B1[2][2];
    const char* cA = (const char*)g.A + (size_t)cur.pm * tstep; const char* cB = (const char*)g.Bt + (size_t)cur.pn * tstep;
    S.a_ready(cur);
    if constexpr (SP2) {
        PG8_STAGE(PG8_SB(0, 0), cB, voffB); PG8_STAGE(PG8_SB(0, 1), cB + hstep, voffB); PG8_STAGE(PG8_SA(0, 0), cA, voffA); PG8_STAGE(PG8_SA(0, 1), cA + hstep, voffA);
        if (wr == 1) PG8_BAR;
        PG8_WAIT_V(2); PG8_BAR;
        PG8_STAGE(PG8_SB(1, 0), cB + kstep, voffB); PG8_STAGE(PG8_SA(1, 0), cA + kstep, voffA); PG8_STAGE(PG8_SB(1, 1), cB + hstep + kstep, voffB);
        PG8_WAIT_V(6); PG8_BAR;
    } else {
        PG8_STAGE(PG8_SB(0, 0), cB, voffB); PG8_STAGE(PG8_SA(0, 0), cA, voffA); PG8_STAGE(PG8_SB(0, 1), cB + hstep, voffB); PG8_STAGE(PG8_SA(0, 1), cA + hstep, voffA);
        if (wr == 1) PG8_BAR;
        PG8_WAIT_V(4); PG8_BAR;
        PG8_STAGE(PG8_SB(1, 0), cB + kstep, voffB); PG8_STAGE(PG8_SA(1, 0), cA + kstep, voffA); PG8_STAGE(PG8_SB(1, 1), cB + hstep + kstep, voffB);
        PG8_WAIT_V(6); PG8_BAR;
    }
    for (;;) {
        const bool has_next = S.next(ui + 1, nxt);
        const char* nA = has_next ? (const char*)g.A + (size_t)nxt.pm * tstep : cA; const char* nB = has_next ? (const char*)g.Bt + (size_t)nxt.pn * tstep : cB;
        for (int t = 0; t < nt; t += 2) {
            const bool last = (t == nt - 2);
            if constexpr (Epi::MIDK) { if (t == (nt >> 1)) E.midk(acc, cur, wr, wc, fr, fq); }
            const char* a1 = cA + (size_t)(t + 1) * kstep;
            const char* a2 = last ? nA : cA + (size_t)(t + 2) * kstep; const char* b2 = last ? nB : cB + (size_t)(t + 2) * kstep;
            const char* a3 = a2 + kstep; const char* b3 = b2 + kstep;
            if (last && has_next) S.a_ready(nxt);
            if constexpr (SP2) {
            PG8_LDB(B0, 0, 0); PG8_LDB(B1, 0, 1); PG8_SCHED; PG8_LDA(At, 0, 0); PG8_STAGE(PG8_SA(1, 1), a1 + hstep, voffA);
            PG8_WAIT_V(8); PG8_WAIT_L(0); PG8_BAR; PG8_MMA(0, 0, At, B0); PG8_MMA(0, 1, At, B1); PG8_BAR; PG8_SCHED;
            PG8_LDA(At, 0, 1); PG8_STAGE(PG8_SB(0, 0), b2, voffB); PG8_STAGE(PG8_SB(0, 1), b2 + hstep, voffB); PG8_STAGE(PG8_SA(0, 0), a2, voffA);
            PG8_WAIT_V(8); PG8_WAIT_L(0); PG8_BAR; PG8_MMA(1, 0, At, B0); PG8_MMA(1, 1, At, B1); PG8_BAR; PG8_SCHED;
            PG8_LDB(B0, 1, 0); PG8_LDB(B1, 1, 1); PG8_SCHED; PG8_LDA(At, 1, 0); PG8_STAGE(PG8_SA(0, 1), a2 + hstep, voffA);
            PG8_WAIT_V(8); PG8_WAIT_L(0); PG8_BAR; PG8_MMA(0, 0, At, B0); PG8_MMA(0, 1, At, B1); PG8_BAR; PG8_SCHED;
            PG8_LDA(At, 1, 1); PG8_STAGE(PG8_SB(1, 0), b3, voffB); PG8_STAGE(PG8_SB(1, 1), b3 + hstep, voffB); PG8_STAGE(PG8_SA(1, 0), a3, voffA);
            PG8_WAIT_V(8); PG8_WAIT_L(0); PG8_BAR; PG8_MMA(1, 0, At, B0); PG8_MMA(1, 1, At, B1); PG8_BAR; PG8_SCHED;
            } else {
            PG8_LDB(B0, 0, 0); PG8_SCHED; PG8_LDA(At, 0, 0); PG8_STAGE(PG8_SA(1, 1), a1 + hstep, voffA);
            PG8_WAIT_L(8); PG8_BAR; PG8_WAIT_L(0); PG8_MMA(0, 0, At, B0); PG8_BAR; PG8_SCHED;
            PG8_LDB(B1, 0, 1); PG8_STAGE(PG8_SB(0, 0), b2, voffB);
            PG8_BAR; PG8_WAIT_L(0); PG8_MMA(0, 1, At, B1); PG8_BAR;
            PG8_LDA(At, 0, 1); PG8_STAGE(PG8_SA(0, 0), a2, voffA);
            PG8_BAR; PG8_WAIT_L(0); PG8_MMA(1, 0, At, B0); PG8_BAR; PG8_SCHED;
            PG8_STAGE(PG8_SB(0, 1), b2 + hstep, voffB);
            PG8_WAIT_V(6); PG8_BAR; PG8_MMA(1, 1, At, B1); PG8_BAR;
            PG8_LDB(B0, 1, 0); PG8_SCHED; PG8_LDA(At, 1, 0); PG8_STAGE(PG8_SA(0, 1), a2 + hstep, voffA);
            PG8_WAIT_L(8); PG8_BAR; PG8_WAIT_L(0); PG8_MMA(0, 0, At, B0); PG8_BAR; PG8_SCHED;
            PG8_LDB(B1, 1, 1); PG8_STAGE(PG8_SB(1, 0), b3, voffB);
            PG8_BAR; PG8_WAIT_L(0); PG8_MMA(0, 1, At, B1); PG8_BAR;
            PG8_LDA(At, 1, 1); PG8_STAGE(PG8_SA(1, 0), a3, voffA);
            PG8_BAR; PG8_WAIT_L(0); PG8_MMA(1, 0, At, B0); PG8_BAR; PG8_SCHED;
            PG8_STAGE(PG8_SB(1, 1), b3 + hstep, voffB);
            PG8_WAIT_V(6); PG8_BAR; PG8_MMA(1, 1, At, B1); PG8_BAR;
            }
        }
        if constexpr (ALIGN_EPI) { if (wr == 0) PG8_BAR; }
        if constexpr (!Epi::AFTER_DRAIN) { E(acc, cur, wr, wc, fr, fq); S.done(cur); }
        if (!has_next) break;
#pragma unroll
        for (int a = 0; a < 2; ++a)
#pragma unroll
            for (int b = 0; b < 2; ++b)
#pragma unroll
                for (int m = 0; m < 4; ++m)
#pragma unroll
                    for (int n = 0; n < 2; ++n) acc[a][b][m][n] = (f32x4){0.f, 0.f, 0.f, 0.f};
        cur = nxt; cA = nA; cB = nB; ++ui;
        if constexpr (ALIGN_EPI) { if (wr == 1) PG8_BAR; }
    }
    PG8_WAIT_V(0);
    if constexpr (!ALIGN_EPI) { if (wr == 0) PG8_BAR; }
    PG8_BAR;
    if constexpr (Epi::AFTER_DRAIN) { E.fused(acc, cur, wr, wc, fr, fq, lds, wid, lane); S.done(cur); }
#undef PG8_SA
#undef PG8_SB
#undef PG8_STAGE
#undef PG8_LDA
#undef PG8_LDB
#undef PG8_MMA
#undef PG8_WAIT_V
#undef PG8_WAIT_L
#undef PG8_BAR
#undef PG8_SCHED
}
}
#define LAS __attribute__((address_space(3)))
#define XB_TMO      128
#define XB_XCNT(j)  (256  + 64 * (j))
#define XB_XSUB(j)  (1280 + 64 * (j))
#define XB_XGEN(j)  (2304 + 64 * (j))
#define XB_TOP      3328
#define XB_TOPGEN   3392
#define XCD_BAR_WORDS 3456
#define XB_SPIN_CAP (1u << 18)

__device__ __forceinline__ unsigned xb_ld(unsigned* p)              { return __hip_atomic_load(p, __ATOMIC_RELAXED, __HIP_MEMORY_SCOPE_AGENT); }
__device__ __forceinline__ unsigned xb_add(unsigned* p, unsigned v) { return __hip_atomic_fetch_add(p, v, __ATOMIC_RELAXED, __HIP_MEMORY_SCOPE_AGENT); }
__device__ __forceinline__ unsigned xb_xcc_id() { return (unsigned)__builtin_amdgcn_s_getreg((3 << 11) | 20) & 0xFu; }
#define XB_SPIN(cond, bar) do { unsigned _sp = 0; while (cond) { __builtin_amdgcn_s_sleep(1); \
    if ((++_sp & 255u) == 0u) { if (xb_ld(&(bar)[XB_TMO])) break; if (_sp > XB_SPIN_CAP) { atomicAdd(&(bar)[XB_TMO], 1u); break; } } } } while (0)

struct XcdBarrier {
    unsigned* bar; unsigned x;
    volatile LAS unsigned* st;
};

__device__ __forceinline__ XcdBarrier xcd_barrier_post(unsigned* bar, volatile LAS unsigned* st) {
    XcdBarrier b; b.bar = bar; b.x = xb_xcc_id(); b.st = st;
    if (threadIdx.x == 0) (void)xb_add(&bar[XB_XCNT(b.x)], 1u);
    return b;
}
__device__ __forceinline__ void xcd_barrier_complete(unsigned* bar, unsigned x, unsigned& nloc, unsigned& nx) {
    const unsigned G = gridDim.x * gridDim.y * gridDim.z;
    unsigned sum, cnt, mine, sp = 0u;
    for (;;) {
        sum = 0u; cnt = 0u; mine = 0u;
#pragma unroll
        for (unsigned j = 0; j < 16; ++j) { const unsigned c = xb_ld(&bar[XB_XCNT(j)]); sum += c; cnt += (c > 0u) ? 1u : 0u; mine = (j == x) ? c : mine; }
        if (sum == G) break;
        __builtin_amdgcn_s_sleep(1);
        if ((++sp & 255u) == 0u) { if (xb_ld(&bar[XB_TMO])) break; if (sp > XB_SPIN_CAP) { atomicAdd(&bar[XB_TMO], 1u); break; } }
    }
    nloc = mine > 0u ? mine : 1u; nx = cnt > 0u ? cnt : 1u;
}

__device__ __forceinline__ void xcd_barrier(const XcdBarrier& b) {
    asm volatile("s_waitcnt vmcnt(0)" ::: "memory");
    __syncthreads();
    if (threadIdx.x == 0) {
        unsigned* bar = b.bar;
        __builtin_amdgcn_s_waitcnt(0);
        unsigned nloc = b.st[0], nx = b.st[1];
        if (nloc == 0u) { xcd_barrier_complete(bar, b.x, nloc, nx); b.st[0] = nloc; b.st[1] = nx; }
        const unsigned old = xb_add(&bar[XB_XSUB(b.x)], 1u);
        const unsigned gen = old / nloc;
        if (old + 1u == (gen + 1u) * nloc) {
            __builtin_amdgcn_fence(__ATOMIC_RELEASE, "agent");
            asm volatile("s_waitcnt vmcnt(0)" ::: "memory");
            const unsigned og = xb_add(&bar[XB_TOP], 1u);
            const unsigned tg = og / nx;
            if (og + 1u == (tg + 1u) * nx) xb_add(&bar[XB_TOPGEN], 1u);
            else XB_SPIN(xb_ld(&bar[XB_TOPGEN]) == tg, bar);
            __builtin_amdgcn_fence(__ATOMIC_ACQUIRE, "agent");
            xb_add(&bar[XB_XGEN(b.x)], 1u);
            asm volatile("s_waitcnt vmcnt(0)" ::: "memory");
        } else {
            XB_SPIN(xb_ld(&bar[XB_XGEN(b.x)]) == gen, bar);
            __builtin_amdgcn_fence(__ATOMIC_ACQUIRE, "agent");
            asm volatile("s_waitcnt vmcnt(0)" ::: "memory");
        }
    }
    __syncthreads();
}


using pg8::bf16_t; using pg8::bf16x8; using pg8::f32x4; using pg8::u32x4; using pg8::cvt_pk_bf16;
constexpr int D = 1024, NBATCH = 8, SEQ = 2048, CTXL = 256;
constexpr int ML = NBATCH * SEQ, MC = NBATCH * CTXL, MT = ML + MC;
constexpr int DIN = 2560, DFF = 4096, DL = 512, NMOD = 6144;
constexpr int NCHUNK = MT / 64;
constexpr int NTHREADS = 512;
constexpr int LDS_BYTES = 147456;

constexpr size_t MiB = 1u << 20;
constexpr size_t WS_MOD = 0;
constexpr size_t WS_BIN = WS_MOD + 2 * 9 * 6144 * 4;
constexpr size_t WS_B1  = WS_BIN + 2 * 9 * 2560 * 4;
constexpr size_t WS_LC  = WS_B1 + 2 * 9 * 4096 * 4;
constexpr size_t WS_WG  = WS_LC + 2 * 512 * 8 * 4;
constexpr size_t WS_CS  = WS_WG + 2 * 8 * 4 * 64 * 64 * 2;
constexpr size_t WS_SSQ = WS_CS + (size_t)NCHUNK * 2 * 2 * 512 * 4;
constexpr size_t WS_YSL = WS_SSQ + (size_t)MT * 16 * 4;
constexpr size_t WS_YSC = WS_YSL + (size_t)MT * 8 * 4;
constexpr size_t WS_SMALL_END = WS_YSC + (size_t)MT * 4;
static_assert(WS_SMALL_END <= 8 * MiB, "small tables");
constexpr size_t WS_BAR = 6 * MiB, BAR_ZERO_BYTES = 16384;
constexpr size_t WS_W = 8 * MiB;
constexpr size_t W_LAYER = 23 * MiB, W_IN = 0, W_OUT = 5 * MiB, W_1 = 7 * MiB, W_2 = 15 * MiB;
constexpr size_t WS_XC = 54 * MiB;
constexpr size_t WS_XS = 62 * MiB;
constexpr size_t WS_H = 98 * MiB;
constexpr size_t WS_U = 98 * MiB;
constexpr size_t WS_Y = 188 * MiB;
constexpr size_t WS_END = 242 * MiB;

struct Args { const float* in[23]; float* out; unsigned char* ws; };
enum { I_X = 0, I_C, I_CTX, I_CCTX, I_ADAW, I_ADAB, I_N1G, I_N2G, I_WIN, I_C4W, I_C4B, I_GAW, I_GAB, I_GXW, I_GXB, I_LAM, I_C3W, I_GOL, I_GOC, I_WOUT, I_W1, I_W2, I_FING };

__device__ __forceinline__ float wave_sum(float v) {
#pragma unroll
    for (int o = 1; o < 64; o <<= 1) v += __shfl_xor(v, o);
    return v;
}
__device__ __forceinline__ float sigmoid_f(float x) { return __builtin_amdgcn_rcpf(1.0f + __builtin_amdgcn_exp2f(-1.44269504089f * x)); }
__device__ __forceinline__ float gelu_tanh(float x) { const float z = 0.7978845608f * (x + 0.044715f * x * x * x); return x * sigmoid_f(2.0f * z); }
__device__ __forceinline__ void unpack8(const u32x4 w, float (&f)[8]) {
    f[0] = __uint_as_float(w.x << 16); f[1] = __uint_as_float(w.x & 0xffff0000u); f[2] = __uint_as_float(w.y << 16); f[3] = __uint_as_float(w.y & 0xffff0000u);
    f[4] = __uint_as_float(w.z << 16); f[5] = __uint_as_float(w.z & 0xffff0000u); f[6] = __uint_as_float(w.w << 16); f[7] = __uint_as_float(w.w & 0xffff0000u);
}
__device__ __forceinline__ u32x4 pack8(const float (&f)[8]) { u32x4 w; w.x = cvt_pk_bf16(f[0], f[1]); w.y = cvt_pk_bf16(f[2], f[3]); w.z = cvt_pk_bf16(f[4], f[5]); w.w = cvt_pk_bf16(f[6], f[7]); return w; }

__device__ __forceinline__ void transpose_item(const float* W, int K, int N, bf16_t* WT, const float* ks, LAS float* scr, int item, int lane) {
    const int nblk = N / 32, kb = item / nblk, nb = item % nblk, k0 = 64 * kb, n0 = 32 * nb;
#pragma unroll 8
    for (int i = 0; i < 32; ++i) { const int kk = 2 * i + (lane >> 5); float v = W[(size_t)(k0 + kk) * N + n0 + (lane & 31)]; if (ks) v *= ks[k0 + kk]; scr[kk * 33 + (lane & 31)] = v; }
    asm volatile("s_waitcnt lgkmcnt(0)" ::: "memory");
    const int c = lane & 7;
#pragma unroll
    for (int j = 0; j < 4; ++j) { const int n = (lane >> 3) + 8 * j; const LAS float* s = scr + (8 * c) * 33 + n;
        u32x4 o; o.x = cvt_pk_bf16(s[0 * 33], s[1 * 33]); o.y = cvt_pk_bf16(s[2 * 33], s[3 * 33]); o.z = cvt_pk_bf16(s[4 * 33], s[5 * 33]); o.w = cvt_pk_bf16(s[6 * 33], s[7 * 33]);
        *(u32x4*)(WT + (size_t)(n0 + n) * K + k0 + 8 * c) = o; }
    asm volatile("s_waitcnt lgkmcnt(0)" ::: "memory");
}

__device__ __forceinline__ void gemv9_item(LAS float* Sx, LAS float* red, const float* W, int N, int n0, float* out, const float* addb, int tid) {
    const int lane = tid & 63, wid = tid >> 6;
    float acc[9];
#pragma unroll
    for (int b = 0; b < 9; ++b) acc[b] = 0.f;
    const float* wp = W + (size_t)(wid * 128) * N + n0 + lane;
#pragma unroll 8
    for (int k = 0; k < 128; ++k) {
        const float wv = wp[(size_t)k * N];
        const LAS float* s = Sx + (wid * 128 + k) * 12;
        const f32x4 s0 = *(const LAS f32x4*)s, s1 = *(const LAS f32x4*)(s + 4); const float s8 = s[8];
        acc[0] += s0[0] * wv; acc[1] += s0[1] * wv; acc[2] += s0[2] * wv; acc[3] += s0[3] * wv;
        acc[4] += s1[0] * wv; acc[5] += s1[1] * wv; acc[6] += s1[2] * wv; acc[7] += s1[3] * wv; acc[8] += s8 * wv;
    }
#pragma unroll
    for (int b = 0; b < 9; ++b) red[(wid * 9 + b) * 64 + lane] = acc[b];
    __syncthreads();
    for (int idx = tid; idx < 576; idx += NTHREADS) {
        const int b = idx >> 6, ln = idx & 63; float s = 0.f;
#pragma unroll
        for (int w = 0; w < 8; ++w) s += red[(w * 9 + b) * 64 + ln];
        out[(size_t)b * N + n0 + ln] = s + (addb ? addb[n0 + ln] : 0.f);
    }
    __syncthreads();
}

struct MixP { const bf16_t* U; bf16_t* Y; float* CS; float* YSL; float* YSC; const bf16_t* WG; const float* LC; const float* c4w; const float* c4b; const float* c3w; };

template <bool APPLY>
__device__ __forceinline__ void lru_unit(LAS unsigned char* lds, const MixP& P, int cgi, int h, int tid) {
    const int lane = tid & 63, wid = tid >> 6;
    LAS bf16_t* Vb = (LAS bf16_t*)lds;
    LAS float* Vf = (LAS float*)(lds + 9216);
    LAS float* AF = Vf + 64 * 68; LAS float* BF = AF + 64 * 68; LAS float* AR = BF + 64 * 68; LAS float* BR = AR + 64 * 68;
    const bool is_ctx = cgi >= 256;
    const int row0 = cgi * 64;
    const int bidx = is_ctx ? ((cgi - 256) >> 2) : (cgi >> 5);
    const int j = is_ctx ? ((cgi - 256) & 3) : (cgi & 31);
    const int tseq0 = j * 64, slen = is_ctx ? CTXL : SEQ;
    {
        const int t = tid >> 3, c8 = (tid & 7) * 8, ch = h * 64 + c8;
        float v[8];
        { const f32x4 b0 = *(const f32x4*)(P.c4b + ch), b1 = *(const f32x4*)(P.c4b + ch + 4); v[0] = b0[0]; v[1] = b0[1]; v[2] = b0[2]; v[3] = b0[3]; v[4] = b1[0]; v[5] = b1[1]; v[6] = b1[2]; v[7] = b1[3]; }
#pragma unroll
        for (int k = 0; k < 4; ++k) {
            const int ts = tseq0 + t + k - 1;
            if (ts >= 0 && ts < slen) {
                const u32x4 w = *(const u32x4*)(P.U + (size_t)(row0 + t + k - 1) * DIN + ch);
                float uf[8]; unpack8(w, uf);
                const f32x4 w0 = *(const f32x4*)(P.c4w + k * DL + ch), w1 = *(const f32x4*)(P.c4w + k * DL + ch + 4);
                v[0] += w0[0] * uf[0]; v[1] += w0[1] * uf[1]; v[2] += w0[2] * uf[2]; v[3] += w0[3] * uf[3];
                v[4] += w1[0] * uf[4]; v[5] += w1[1] * uf[5]; v[6] += w1[2] * uf[6]; v[7] += w1[3] * uf[7];
            }
        }
        *(LAS u32x4*)(Vb + t * 72 + c8) = pack8(v);
        *(LAS f32x4*)(Vf + t * 68 + c8) = (f32x4){v[0], v[1], v[2], v[3]};
        *(LAS f32x4*)(Vf + t * 68 + c8 + 4) = (f32x4){v[4], v[5], v[6], v[7]};
    }
    float carry = 0.f;
    if (APPLY && wid < 2) {
        const int dir = wid;
        const float* cs = P.CS + (size_t)dir * 1024 + h * 64 + lane;
        const int cbase = 256 + 4 * bidx, sbase = is_ctx ? cbase : 32 * bidx, sn = is_ctx ? 4 : 32;
        if (dir == 0) {
            if (!is_ctx) for (int c = 0; c < 4; ++c) { const float* p = cs + (size_t)(cbase + c) * 2048; carry = p[0] * carry + p[512]; }
            for (int c = 0; c < j; ++c) { const float* p = cs + (size_t)(sbase + c) * 2048; carry = p[0] * carry + p[512]; }
        } else {
            if (!is_ctx) for (int c = 3; c >= 0; --c) { const float* p = cs + (size_t)(cbase + c) * 2048; carry = p[0] * carry + p[512]; }
            for (int c = sn - 1; c > j; --c) { const float* p = cs + (size_t)(sbase + c) * 2048; carry = p[0] * carry + p[512]; }
        }
    }
    __syncthreads();
    {
        const int fr = lane & 15, fq = lane >> 4, mt = wid >> 1;
        bf16x8 vfrag[2];
#pragma unroll
        for (int ks = 0; ks < 2; ++ks) vfrag[ks] = *(const LAS bf16x8*)(Vb + (16 * mt + fr) * 72 + ks * 32 + fq * 8);
        const bf16_t* wg = P.WG + (size_t)h * 4 * 4096;
        const int t = 16 * mt + fr;
#pragma unroll
        for (int cqi = 0; cqi < 2; ++cqi) {
            const int cq = 2 * (wid & 1) + cqi;
            f32x4 acc[4];
#pragma unroll
            for (int g = 0; g < 4; ++g) {
                acc[g] = (f32x4){0.f, 0.f, 0.f, 0.f};
#pragma unroll
                for (int ks = 0; ks < 2; ++ks) {
                    const bf16x8 wf = *(const bf16x8*)(wg + g * 4096 + (16 * cq + fr) * 64 + ks * 32 + fq * 8);
                    acc[g] = __builtin_amdgcn_mfma_f32_16x16x32_bf16(wf, vfrag[ks], acc[g], 0, 0, 0);
                }
            }
            const int c0 = 16 * cq + 4 * fq;
            const f32x4 vv = *(const LAS f32x4*)(Vf + t * 68 + c0);
            f32x4 af, bf, ar, br;
#pragma unroll
            for (int r = 0; r < 4; ++r) {
                const float* lc = P.LC + (size_t)(h * 64 + c0 + r) * 8;
                const f32x4 l0 = *(const f32x4*)lc, l1 = *(const f32x4*)(lc + 4);
                { const float rr = sigmoid_f(acc[0][r] + l0[0]), ii = sigmoid_f(acc[1][r] + l0[1]); const float a = __builtin_amdgcn_exp2f(-l0[2] * rr);
                  af[r] = a; bf[r] = __builtin_amdgcn_sqrtf(fmaxf(1.0f - a * a, 0.f)) * (ii * vv[r]); }
                { const float rr = sigmoid_f(acc[2][r] + l0[3]), ii = sigmoid_f(acc[3][r] + l1[0]); const float a = __builtin_amdgcn_exp2f(-l1[1] * rr);
                  ar[r] = a; br[r] = __builtin_amdgcn_sqrtf(fmaxf(1.0f - a * a, 0.f)) * (ii * vv[r]); }
            }
            *(LAS f32x4*)(AF + t * 68 + c0) = af; *(LAS f32x4*)(BF + t * 68 + c0) = bf; *(LAS f32x4*)(AR + t * 68 + c0) = ar; *(LAS f32x4*)(BR + t * 68 + c0) = br;
        }
    }
    __syncthreads();
    if (wid < 2) {
        const int dir = wid;
        LAS float* Aa = dir ? AR : AF; LAS float* Bb = dir ? BR : BF;
        float hst = carry, pp = 1.f;
#pragma unroll 8
        for (int s = 0; s < 64; ++s) {
            const int t = dir ? 63 - s : s;
            const float a = Aa[t * 68 + lane], b = Bb[t * 68 + lane];
            hst = a * hst + b;
            if (APPLY) Bb[t * 68 + lane] = hst; else pp *= a;
        }
        if (!APPLY) { float* cs = P.CS + (size_t)cgi * 2048 + dir * 1024 + h * 64 + lane; cs[0] = pp; cs[512] = hst; }
    }
    if (APPLY) {
        __syncthreads();
        const int t = tid >> 3, c8 = (tid & 7) * 8, row = row0 + t;
        const u32x4 gw = *(const u32x4*)(P.U + (size_t)row * DIN + DL + h * 64 + c8);
        float gf[8]; unpack8(gw, gf);
        const f32x4 f0 = *(const LAS f32x4*)(BF + t * 68 + c8), f1 = *(const LAS f32x4*)(BF + t * 68 + c8 + 4);
        const f32x4 r0 = *(const LAS f32x4*)(BR + t * 68 + c8), r1 = *(const LAS f32x4*)(BR + t * 68 + c8 + 4);
        float y[8]; float ss = 0.f;
#pragma unroll
        for (int q = 0; q < 4; ++q) { y[q] = gelu_tanh(gf[q]) * (f0[q] + r0[q]); y[q + 4] = gelu_tanh(gf[q + 4]) * (f1[q] + r1[q]); }
#pragma unroll
        for (int q = 0; q < 8; ++q) ss += y[q] * y[q];
        *(u32x4*)(P.Y + (size_t)row * D + h * 64 + c8) = pack8(y);
        ss += __shfl_xor(ss, 1); ss += __shfl_xor(ss, 2); ss += __shfl_xor(ss, 4);
        if ((tid & 7) == 0) P.YSL[(size_t)row * 8 + h] = ss;
    }
    __syncthreads();
}

__device__ __forceinline__ void conv_unit(const MixP& P, int cgi, int tid) {
    const bool is_ctx = cgi >= 256;
    const int tok = tid >> 3, sub = tid & 7, row = cgi * 64 + tok;
    const int tseq = (is_ctx ? ((cgi - 256) & 3) : (cgi & 31)) * 64 + tok;
    const bf16_t* ur = P.U + (size_t)row * DIN;
    float ss = 0.f;
#pragma unroll 2
    for (int q = 0; q < 8; ++q) {
        const int ch = q * 64 + sub * 8;
        int d; bool vm, vp;
        if (is_ctx) { d = 1; vm = tseq >= 1; vp = tseq + 1 < CTXL; }
        else if (q < 4) { d = 1; vm = tok >= 1; vp = tok < 63; }
        else { d = 64; vm = tseq >= 64; vp = tseq + 64 < SEQ; }
        float acc[8], xa[8], ca[8];
        { unpack8(*(const u32x4*)(ur + 1024 + ch), xa); unpack8(*(const u32x4*)(ur + 2048 + ch), ca);
          const f32x4 w0 = *(const f32x4*)(P.c3w + DL + ch), w1 = *(const f32x4*)(P.c3w + DL + ch + 4);
#pragma unroll
          for (int i = 0; i < 4; ++i) { acc[i] = w0[i] * (xa[i] * ca[i]); acc[i + 4] = w1[i] * (xa[i + 4] * ca[i + 4]); } }
        if (vm) { const bf16_t* un = ur - (size_t)d * DIN; unpack8(*(const u32x4*)(un + 1024 + ch), xa); unpack8(*(const u32x4*)(un + 2048 + ch), ca);
          const f32x4 w0 = *(const f32x4*)(P.c3w + ch), w1 = *(const f32x4*)(P.c3w + ch + 4);
#pragma unroll
          for (int i = 0; i < 4; ++i) { acc[i] += w0[i] * (xa[i] * ca[i]); acc[i + 4] += w1[i] * (xa[i + 4] * ca[i + 4]); } }
        if (vp) { const bf16_t* un = ur + (size_t)d * DIN; unpack8(*(const u32x4*)(un + 1024 + ch), xa); unpack8(*(const u32x4*)(un + 2048 + ch), ca);
          const f32x4 w0 = *(const f32x4*)(P.c3w + 2 * DL + ch), w1 = *(const f32x4*)(P.c3w + 2 * DL + ch + 4);
#pragma unroll
          for (int i = 0; i < 4; ++i) { acc[i] += w0[i] * (xa[i] * ca[i]); acc[i + 4] += w1[i] * (xa[i + 4] * ca[i + 4]); } }
        float bg[8]; unpack8(*(const u32x4*)(ur + 1536 + ch), bg);
#pragma unroll
        for (int i = 0; i < 8; ++i) { acc[i] *= bg[i]; ss += acc[i] * acc[i]; }
        *(u32x4*)(P.Y + (size_t)row * D + DL + ch) = pack8(acc);
    }
    ss += __shfl_xor(ss, 1); ss += __shfl_xor(ss, 2); ss += __shfl_xor(ss, 4);
    if (sub == 0) P.YSC[row] = ss;
}

__global__ void __launch_bounds__(NTHREADS, 2) fwd_megakernel(Args args) {
    extern __shared__ __attribute__((aligned(16))) unsigned char lds_raw[];
    LAS unsigned char* lds = (LAS unsigned char*)lds_raw;
    const int tid = threadIdx.x, lane = tid & 63, wid = __builtin_amdgcn_readfirstlane(tid >> 6);
    const int G = gridDim.x, bx = blockIdx.x;
    unsigned char* ws = args.ws;
    float* MOD = (float*)(ws + WS_MOD); float* BIN = (float*)(ws + WS_BIN); float* B1 = (float*)(ws + WS_B1); float* LC = (float*)(ws + WS_LC);
    bf16_t* WG = (bf16_t*)(ws + WS_WG); float* CS = (float*)(ws + WS_CS); float* SSQ = (float*)(ws + WS_SSQ); float* YSL = (float*)(ws + WS_YSL); float* YSC = (float*)(ws + WS_YSC);
    float* XC = (float*)(ws + WS_XC); bf16_t* XS = (bf16_t*)(ws + WS_XS); bf16_t* HB = (bf16_t*)(ws + WS_H); bf16_t* U = (bf16_t*)(ws + WS_U); bf16_t* Y = (bf16_t*)(ws + WS_Y);
    const int gw = bx * 8 + wid, NGW = G * 8;
    volatile LAS unsigned* bst = (volatile LAS unsigned*)(lds + 131072 + 64);
    if (tid < 2) bst[tid] = 0u;
    __syncthreads();
    const XcdBarrier bar = xcd_barrier_post((unsigned*)(ws + WS_BAR), bst);
#define GRID_BAR() xcd_barrier(bar)

    {
        LAS float* Sx = (LAS float*)lds; LAS float* red = (LAS float*)(lds + 49152);
        bool loaded = false;
        for (int it = bx; it < 2 * (NMOD / 64); it += G) {
            if (!loaded) {
                for (int idx = tid; idx < 9 * 1024; idx += NTHREADS) { const int b = idx >> 10, k = idx & 1023; const float c = b < 8 ? args.in[I_C][b * 1024 + k] : args.in[I_CCTX][k]; Sx[k * 12 + b] = c * sigmoid_f(c); }
                __syncthreads(); loaded = true;
            }
            const int l = it / (NMOD / 64), n0 = (it % (NMOD / 64)) * 64;
            gemv9_item(Sx, red, args.in[I_ADAW] + (size_t)l * D * NMOD, NMOD, n0, MOD + (size_t)l * 9 * NMOD, args.in[I_ADAB] + (size_t)l * NMOD, tid);
        }
        __syncthreads();
        LAS float* scr = (LAS float*)(lds + wid * 16384);
        constexpr int T_IN = (D / 64) * (DIN / 32), T_OUT = (D / 64) * (D / 32), T_1 = (D / 64) * (DFF / 32), T_2 = (DFF / 64) * (D / 32), T_L = T_IN + T_OUT + T_1 + T_2;
        for (int it = gw; it < 2 * T_L; it += NGW) {
            const int l = it / T_L; int r = it % T_L;
            bf16_t* wl = (bf16_t*)(ws + WS_W + (size_t)l * W_LAYER);
            if (r < T_IN) { transpose_item(args.in[I_WIN] + (size_t)l * D * DIN, D, DIN, (bf16_t*)((unsigned char*)wl + W_IN), nullptr, scr, r, lane); continue; } r -= T_IN;
            if (r < T_OUT) {
                const int kb = r / (D / 32); const float* ks = kb < 8 ? args.in[I_GOL] + (size_t)l * DL : args.in[I_GOC] + (size_t)l * DL - DL;
                transpose_item(args.in[I_WOUT] + (size_t)l * D * D, D, D, (bf16_t*)((unsigned char*)wl + W_OUT), ks, scr, r, lane); continue; } r -= T_OUT;
            if (r < T_1) { transpose_item(args.in[I_W1] + (size_t)l * D * DFF, D, DFF, (bf16_t*)((unsigned char*)wl + W_1), nullptr, scr, r, lane); continue; } r -= T_1;
            transpose_item(args.in[I_W2] + (size_t)l * DFF * D, DFF, D, (bf16_t*)((unsigned char*)wl + W_2), nullptr, scr, r, lane);
        }
        for (int idx = bx * NTHREADS + tid; idx < 2 * 8 * 4 * 64 * 64; idx += G * NTHREADS) {
            const int d = idx & 63, e = (idx >> 6) & 63, g = (idx >> 12) & 3, h = (idx >> 14) & 7, l = idx >> 17;
            const float* src = (g & 1) ? args.in[I_GXW] : args.in[I_GAW];
            const float v = src[((size_t)((l * 2 + (g >> 1)) * 8 + h) * 64 + d) * 64 + e];
            WG[idx] = (bf16_t)(cvt_pk_bf16(v, 0.f) & 0xffffu);
        }
        for (int idx = bx * NTHREADS + tid; idx < 2 * DL; idx += G * NTHREADS) {
            const int l = idx / DL, ch = idx % DL; float* lc = LC + (size_t)idx * 8;
            const float lf = args.in[I_LAM][(l * 2 + 0) * DL + ch], lr = args.in[I_LAM][(l * 2 + 1) * DL + ch];
            lc[0] = args.in[I_GAB][(l * 2 + 0) * DL + ch]; lc[1] = args.in[I_GXB][(l * 2 + 0) * DL + ch]; lc[2] = 8.0f * log1pf(expf(-lf)) * 1.44269504089f;
            lc[3] = args.in[I_GAB][(l * 2 + 1) * DL + ch]; lc[4] = args.in[I_GXB][(l * 2 + 1) * DL + ch]; lc[5] = 8.0f * log1pf(expf(-lr)) * 1.44269504089f;
            lc[6] = 0.f; lc[7] = 0.f;
        }
    }
    cg::this_grid().sync();
    {
        LAS float* Sx = (LAS float*)lds; LAS float* red = (LAS float*)(lds + 49152);
        constexpr int NI_IN = DIN / 64, NI_1 = DFF / 64, NI_L = NI_IN + NI_1;
        for (int it = bx; it < 2 * NI_L; it += G) {
            const int l = it / NI_L, r = it % NI_L; const bool is1 = r >= NI_IN;
            const float* sh = MOD + (size_t)l * 9 * NMOD + (is1 ? 3 * D : 0);
            __syncthreads();
            for (int idx = tid; idx < 9 * 1024; idx += NTHREADS) { const int b = idx >> 10, k = idx & 1023; Sx[k * 12 + b] = sh[(size_t)b * NMOD + k]; }
            __syncthreads();
            if (!is1) gemv9_item(Sx, red, args.in[I_WIN] + (size_t)l * D * DIN, DIN, r * 64, BIN + (size_t)l * 9 * DIN, nullptr, tid);
            else gemv9_item(Sx, red, args.in[I_W1] + (size_t)l * D * DFF, DFF, (r - NI_IN) * 64, B1 + (size_t)l * 9 * DFF, nullptr, tid);
        }
        for (int m = gw; m < MT; m += NGW) {
            const bool lat = m < ML; const int b = lat ? m / SEQ : 8;
            const float* xr = lat ? args.in[I_X] + (size_t)m * D : args.in[I_CTX] + (size_t)(m - ML) * D;
            const float* sc = MOD + (size_t)b * NMOD + D; const float* ng = args.in[I_N1G];
            float s = 0.f;
#pragma unroll
            for (int q = 0; q < 4; ++q) {
                const int c = q * 256 + lane * 4;
                const f32x4 v = *(const f32x4*)(xr + c), g = *(const f32x4*)(ng + c), sv = *(const f32x4*)(sc + c);
                s += (v[0] * v[0] + v[1] * v[1]) + (v[2] * v[2] + v[3] * v[3]);
                const f32x4 z = v * (g * (sv + 1.0f));
                unsigned long long o = (unsigned long long)cvt_pk_bf16(z[0], z[1]) | ((unsigned long long)cvt_pk_bf16(z[2], z[3]) << 32);
                *(unsigned long long*)(XS + (size_t)m * D + c) = o;
            }
            s = wave_sum(s);
            if (lane < 16) SSQ[(size_t)m * 16 + lane] = lane == 0 ? s : 0.f;
        }
    }
    GRID_BAR();

#pragma nounroll
    for (int l = 0; l < 2; ++l) {
        const bool lastl = (l == 1);
        const float* modl = MOD + (size_t)l * 9 * NMOD;
        const unsigned char* wl = ws + WS_W + (size_t)l * W_LAYER;
        const int nMall = lastl ? 64 : 72;
        {
            pg8::Gemm g{XS, (const bf16_t*)(wl + W_IN), MT, DIN, D};
            pg8::Order S; S.init(nMall, DIN / 256, G, bx, 64, lastl ? 16 : 0);
            pg8::EpiLin<0> E{U, DIN, BIN + (size_t)l * 9 * DIN, DIN, SSQ};
            pg8::gemm_phase<pg8::EpiLin<0>, pg8::Order, true, true>(lds, g, S, E);
        }
        GRID_BAR();
        MixP P{U, Y, CS, YSL, YSC, WG + (size_t)l * 8 * 4 * 4096, LC + (size_t)l * DL * 8, args.in[I_C4W] + (size_t)l * 4 * DL, args.in[I_C4B] + (size_t)l * DL, args.in[I_C3W] + (size_t)l * 3 * DL};
        {
            const int n_lru = NCHUNK * 8, n_conv = lastl ? 256 : NCHUNK;
            int mtid = threadIdx.x; asm volatile("" : "+v"(mtid));
            for (int it = bx; it < n_lru + n_conv; it += G) {
                if (it < n_lru) lru_unit<false>(lds, P, it >> 3, it & 7, mtid);
                else conv_unit(P, it - n_lru, mtid);
            }
        }
        GRID_BAR();
        {
            const int n_lru = (lastl ? 256 : NCHUNK) * 8;
            int mtid = threadIdx.x; asm volatile("" : "+v"(mtid));
            for (int it = bx; it < n_lru; it += G) lru_unit<true>(lds, P, it >> 3, it & 7, mtid);
        }
        GRID_BAR();
        {
            pg8::Gemm g{Y, (const bf16_t*)(wl + W_OUT), MT, D, D};
            pg8::Order S; S.init(nMall, D / 256, G, bx, 0, 0);
            pg8::EpiRes<true> E{l == 0 ? args.in[I_X] : args.out, l == 0 ? args.in[I_CTX] : XC, args.out, XC, modl + 2 * D, modl + 4 * D, args.in[I_N2G] + (size_t)l * D, XS, SSQ, YSL, YSC};
            pg8::gemm_phase<pg8::EpiRes<true>, pg8::Order, true, true>(lds, g, S, E);
        }
        GRID_BAR();
        {
            pg8::Gemm g{XS, (const bf16_t*)(wl + W_1), MT, DFF, D};
            pg8::Order S; S.init(nMall, DFF / 256, G, bx, 0, 0);
            pg8::EpiLin<1> E{HB, DFF, B1 + (size_t)l * 9 * DFF, DFF, SSQ};
            pg8::gemm_phase<pg8::EpiLin<1>, pg8::Order, true, true>(lds, g, S, E);
        }
        GRID_BAR();
        {
            pg8::Gemm g{HB, (const bf16_t*)(wl + W_2), MT, D, DFF};
            pg8::Order S; S.init(nMall, D / 256, G, bx, 0, 0);
            const float* nsc = lastl ? nullptr : (MOD + (size_t)(l + 1) * 9 * NMOD + D);
            pg8::EpiRes<false> E{args.out, XC, args.out, XC, modl + 5 * D, nsc, args.in[I_N1G] + (size_t)(lastl ? 0 : (l + 1)) * D, XS, SSQ, YSL, YSC};
            pg8::gemm_phase<pg8::EpiRes<false>, pg8::Order, true, true>(lds, g, S, E);
        }
        GRID_BAR();
    }
    int flane = lane; asm volatile("" : "+v"(flane));
    for (int m = gw; m < ML; m += NGW) {
        const f32x4 a = *(const f32x4*)(SSQ + (size_t)m * 16), b = *(const f32x4*)(SSQ + (size_t)m * 16 + 4), c = *(const f32x4*)(SSQ + (size_t)m * 16 + 8), d = *(const f32x4*)(SSQ + (size_t)m * 16 + 12);
        const float s = (((a[0] + a[1]) + (a[2] + a[3])) + ((b[0] + b[1]) + (b[2] + b[3]))) + (((c[0] + c[1]) + (c[2] + c[3])) + ((d[0] + d[1]) + (d[2] + d[3])));
        const float rs = 1.0f / sqrtf(s * (1.0f / 1024.0f) + pg8::RMS_EPS);
        float* xr = args.out + (size_t)m * D;
#pragma unroll
        for (int q = 0; q < 4; ++q) { const int cc = q * 256 + flane * 4; const f32x4 v = *(const f32x4*)(xr + cc), g = *(const f32x4*)(args.in[I_FING] + cc); *(f32x4*)(xr + cc) = v * rs * g; }
    }
}

extern "C" void kernel_launch(void* const* d_in, const int* in_sizes, int n_in, void* d_out, int out_size, void* d_ws, size_t ws_size, hipStream_t stream) {
    static int grid_blocks = 0;
    if (grid_blocks == 0) {
        if (n_in != 23 || out_size != ML * D || ws_size < WS_END) { fprintf(stderr, "kernel_launch: unexpected problem (n_in %d out %d ws %zu)\n", n_in, out_size, ws_size); grid_blocks = -1; return; }
        int dev = 0, cus = 0, per_cu = 0;
        hipGetDevice(&dev);
        hipDeviceGetAttribute(&cus, hipDeviceAttributeMultiprocessorCount, dev);
        if (hipFuncSetAttribute((const void*)fwd_megakernel, hipFuncAttributeMaxDynamicSharedMemorySize, LDS_BYTES) != hipSuccess) { fprintf(stderr, "kernel_launch: hipFuncSetAttribute failed\n"); grid_blocks = -1; return; }
        if (hipOccupancyMaxActiveBlocksPerMultiprocessor(&per_cu, (const void*)fwd_megakernel, NTHREADS, LDS_BYTES) != hipSuccess || per_cu < 1) { fprintf(stderr, "kernel_launch: occupancy query failed (%d)\n", per_cu); per_cu = 1; }
        (void)hipGetLastError();
        grid_blocks = cus * 1;
        fprintf(stderr, "kernel_launch: cus %d per_cu %d grid %d\n", cus, per_cu, grid_blocks);
    }
    if (grid_blocks < 0) return;
    if (hipMemsetAsync((unsigned char*)d_ws + WS_BAR, 0, BAR_ZERO_BYTES, stream) != hipSuccess) { fprintf(stderr, "kernel_launch: memset failed\n"); return; }
    Args a{};
    for (int i = 0; i < 23; ++i) a.in[i] = (const float*)d_in[i];
    a.out = (float*)d_out; a.ws = (unsigned char*)d_ws;
    void* kargs[] = {&a};
    hipError_t e = hipLaunchCooperativeKernel((const void*)fwd_megakernel, dim3(grid_blocks), dim3(NTHREADS), kargs, LDS_BYTES, stream);
    if (e != hipSuccess) fprintf(stderr, "kernel_launch: cooperative launch failed: %s (grid %d)\n", hipGetErrorString(e), grid_blocks);
}
```

```cpp
#include <hip/hip_runtime.h>
#include <hip/hip_cooperative_groups.h>
#include <cstdio>
#include <cstdint>
namespace cg = cooperative_groups;
namespace pg8 {
#define PG8_LAS __attribute__((address_space(3)))
typedef unsigned short bf16_t;
typedef short bf16x8 __attribute__((ext_vector_type(8)));
typedef float f32x4 __attribute__((ext_vector_type(4)));
typedef unsigned u32x4 __attribute__((ext_vector_type(4)));
constexpr int BM = 256, BK = 64, HALF = 128, HTB = HALF * BK * 2  , STAGE_BYTES = 8 * HTB, NXCD = 8, WGM = 8;

__host__ __device__ __forceinline__ int lds_byte(int r, int c) { const int st = (r >> 4) * 2 + (c >> 5), rr = r & 15, cc = c & 31, ob = rr * 64 + cc * 2; return st * 1024 + (ob ^ (((ob >> 9) & 1) << 5)); }
__host__ __device__ __forceinline__ void stage_rc(int b, int& R, int& C) { const int st = b / 1024, sb = b % 1024, swz = sb ^ (((sb >> 9) & 1) << 5); R = (st >> 1) * 16 + swz / 64; C = (st & 1) * 32 + (swz % 64) / 2; }
__host__ __device__ __forceinline__ int perm32(int rho) { const int n = rho >> 4, i = rho & 15; return 8 * (i >> 2) + 4 * n + (i & 3); }

struct Unit { int pm, pn; };
struct Gemm { const bf16_t* A; const bf16_t* Bt; int M, N, K; };

struct StaticOrder {
    int nM, nN, nwg, G, c;
    __host__ __device__ void init(int M, int N, int G_, int c_) { nM = M / BM; nN = N / BM; nwg = nM * nN; G = G_; c = c_; }
    __host__ __device__ bool next(int i, Unit& u) const {
        const long L = (long)i * G + c; if (L >= nwg) return false;
        int wgid = (int)L; { const int q = nwg / NXCD, r = nwg % NXCD, xcd = wgid % NXCD, off = wgid / NXCD; wgid = (xcd < r ? xcd * (q + 1) : r * (q + 1) + (xcd - r) * q) + off; }
        const int nig = WGM * nN, gid = wgid / nig, fm = gid * WGM, gsz = (nM - fm) < WGM ? (nM - fm) : WGM;
        u.pm = fm + ((wgid % nig) % gsz); u.pn = (wgid % nig) / gsz; return true;
    }
    __device__ __forceinline__ void a_ready(const Unit&) const {}
    __device__ __forceinline__ void done(const Unit&) const {}
};

__device__ __forceinline__ unsigned cvt_pk_bf16(float lo, float hi) { unsigned r; asm volatile("v_cvt_pk_bf16_f32 %0, %1, %2" : "=v"(r) : "v"(lo), "v"(hi)); return r; }
typedef float f32x2 __attribute__((ext_vector_type(2)));
struct Order {
    int nM, nN, nwg, G, c, xM0, nX;
    __device__ void init(int nM_, int nN_, int G_, int c_, int xM0_, int nX_) { nM = nM_; nN = nN_; nwg = nM * nN; G = G_; c = c_; xM0 = xM0_; nX = nX_; }
    __device__ bool next(int i, Unit& u) const {
        const long L = (long)i * G + c;
        if (L >= nwg) { const int j = (int)(L - nwg); if (j >= nX) return false; u.pm = xM0 + (j & 7); u.pn = j >> 3; return true; }
        int wgid = (int)L; { const int q = nwg / NXCD, r = nwg % NXCD, xcd = wgid % NXCD, off = wgid / NXCD; wgid = (xcd < r ? xcd * (q + 1) : r * (q + 1) + (xcd - r) * q) + off; }
        const int nig = WGM * nN, gid = wgid / nig, fm = gid * WGM, gsz = (nM - fm) < WGM ? (nM - fm) : WGM;
        u.pm = fm + ((wgid % nig) % gsz); u.pn = (wgid % nig) / gsz; return true;
    }
    __device__ __forceinline__ void a_ready(const Unit&) const {}
    __device__ __forceinline__ void done(const Unit&) const {}
};

constexpr int ROWS_LAT = 16384;
constexpr float RMS_EPS = 1e-6f;

template <int ACT> struct EpiLin {
    static constexpr bool PERM = true, AFTER_DRAIN = false, MIDK = false;
    bf16_t* O; int ldc; const float* bias; int nb; const float* ssq;
    __device__ __forceinline__ void midk(f32x4 (&)[2][2][4][2], const Unit&, int, int, int, int) const {}
    __device__ __forceinline__ void operator()(const f32x4 (&acc)[2][2][4][2], const Unit& u, int wr, int wc, int fr, int fq) const {
        asm volatile("" : "+v"(fr), "+v"(fq));
        const int b = u.pm < 64 ? (u.pm >> 3) : 8;
        const int row0 = u.pm * BM + wr * 64 + fr, col0 = u.pn * BM + wc * 32 + 8 * fq;
        f32x4 bv[2][2];
#pragma unroll
        for (int bj = 0; bj < 2; ++bj)
#pragma unroll
            for (int n = 0; n < 2; ++n) bv[bj][n] = *(const f32x4*)(bias + (size_t)b * nb + col0 + bj * HALF + 4 * n);
#pragma unroll
        for (int ai = 0; ai < 2; ++ai)
#pragma unroll
            for (int m = 0; m < 4; ++m) {
                const int row = row0 + ai * HALF + m * 16;
                const f32x4 p = *(const f32x4*)(ssq + (size_t)row * 16 + 4 * fq);
                float s = (p[0] + p[1]) + (p[2] + p[3]); s += __shfl_xor(s, 16); s += __shfl_xor(s, 32);
                const float rs = __builtin_amdgcn_rsqf(s * (1.0f / 1024.0f) + RMS_EPS);
                bf16_t* rowp = O + (size_t)row * ldc + col0;
#pragma unroll
                for (int bj = 0; bj < 2; ++bj) {
                    f32x4 v0 = acc[ai][bj][m][0] * rs + bv[bj][0], v1 = acc[ai][bj][m][1] * rs + bv[bj][1];
                    if (ACT == 1) {
#pragma unroll
                        for (int j = 0; j < 4; ++j) { const float a = fmaxf(v0[j], 0.f), c = fmaxf(v1[j], 0.f); v0[j] = a * a; v1[j] = c * c; }
                    }
                    u32x4 w; w.x = cvt_pk_bf16(v0[0], v0[1]); w.y = cvt_pk_bf16(v0[2], v0[3]); w.z = cvt_pk_bf16(v1[0], v1[1]); w.w = cvt_pk_bf16(v1[2], v1[3]);
                    *(u32x4*)(rowp + bj * HALF) = w;
                }
                asm volatile("" ::: "memory");
            }
    }
};

template <bool MID> struct EpiRes {
    static constexpr bool PERM = true, AFTER_DRAIN = false, MIDK = MID;
    const float* xin_lat; const float* xin_ctx; float* xout_lat; float* xout_ctx;
    const float* gate;
    const float* nsc;
    const float* ng;
    bf16_t* xs; float* ssq; const float* ysl; const float* ysc;
    __device__ __forceinline__ void midk(f32x4 (&acc)[2][2][4][2], const Unit& u, int wr, int wc, int fr, int fq) const {
        asm volatile("" : "+v"(fr));
        const int row0 = u.pm * BM + wr * 64 + fr;
#pragma unroll
        for (int ai = 0; ai < 2; ++ai)
#pragma unroll
            for (int m = 0; m < 4; ++m) {
                const int row = row0 + ai * HALF + m * 16;
                const f32x4 a = *(const f32x4*)(ysl + (size_t)row * 8), c = *(const f32x4*)(ysl + (size_t)row * 8 + 4);
                const float sl = ((a[0] + a[1]) + (a[2] + a[3])) + ((c[0] + c[1]) + (c[2] + c[3]));
                const float rl = __builtin_amdgcn_rsqf(sl * (1.0f / 512.0f) + RMS_EPS);
                const float qc = ysc[row] * (1.0f / 512.0f) + RMS_EPS;
                const float ratio = rl * __builtin_amdgcn_sqrtf(qc);
#pragma unroll
                for (int bj = 0; bj < 2; ++bj)
#pragma unroll
                    for (int n = 0; n < 2; ++n) acc[ai][bj][m][n] = acc[ai][bj][m][n] * ratio;
                asm volatile("" ::: "memory");
            }
    }
    __device__ __forceinline__ void operator()(const f32x4 (&acc)[2][2][4][2], const Unit& u, int wr, int wc, int fr, int fq) const {
        asm volatile("" : "+v"(fr), "+v"(fq));
        const bool lat = u.pm < 64;
        const int b = lat ? (u.pm >> 3) : 8;
        const int row0 = u.pm * BM + wr * 64 + fr, col0 = u.pn * BM + wc * 32 + 8 * fq;
        const int rbase = lat ? 0 : ROWS_LAT;
        const float* xi = lat ? xin_lat : xin_ctx; float* xo = lat ? xout_lat : xout_ctx;
        f32x4 gv[2][2], nv[2][2];
#pragma unroll
        for (int bj = 0; bj < 2; ++bj)
#pragma unroll
            for (int n = 0; n < 2; ++n) {
                const int c = col0 + bj * HALF + 4 * n;
                gv[bj][n] = *(const f32x4*)(gate + (size_t)b * 6144 + c);
                if (nsc) { const f32x4 s = *(const f32x4*)(nsc + (size_t)b * 6144 + c), g = *(const f32x4*)(ng + c); nv[bj][n] = g * (s + 1.0f); }
                else nv[bj][n] = (f32x4){0.f, 0.f, 0.f, 0.f};
            }
#pragma unroll
        for (int ai = 0; ai < 2; ++ai)
#pragma unroll
            for (int m = 0; m < 4; ++m) {
                const int row = row0 + ai * HALF + m * 16;
                float send = 1.0f;
                if (MID) send = __builtin_amdgcn_rsqf(ysc[row] * (1.0f / 512.0f) + RMS_EPS);
                const size_t off = (size_t)(row - rbase) * 1024 + col0;
                float ss = 0.f;
#pragma unroll
                for (int bj = 0; bj < 2; ++bj) {
                    const f32x4 x0 = *(const f32x4*)(xi + off + bj * HALF), x1 = *(const f32x4*)(xi + off + bj * HALF + 4);
                    const f32x4 y0 = x0 + gv[bj][0] * (acc[ai][bj][m][0] * send), y1 = x1 + gv[bj][1] * (acc[ai][bj][m][1] * send);
                    *(f32x4*)(xo + off + bj * HALF) = y0; *(f32x4*)(xo + off + bj * HALF + 4) = y1;
                    ss += (y0[0] * y0[0] + y0[1] * y0[1]) + (y0[2] * y0[2] + y0[3] * y0[3]);
                    ss += (y1[0] * y1[0] + y1[1] * y1[1]) + (y1[2] * y1[2] + y1[3] * y1[3]);
                    if (nsc) {
                        const f32x4 z0 = y0 * nv[bj][0], z1 = y1 * nv[bj][1];
                        u32x4 w; w.x = cvt_pk_bf16(z0[0], z0[1]); w.y = cvt_pk_bf16(z0[2], z0[3]); w.z = cvt_pk_bf16(z1[0], z1[1]); w.w = cvt_pk_bf16(z1[2], z1[3]);
                        *(u32x4*)(xs + (size_t)row * 1024 + col0 + bj * HALF) = w;
                    }
                }
                ss += __shfl_xor(ss, 16); ss += __shfl_xor(ss, 32);
                if (fq == 0) ssq[(size_t)row * 16 + u.pn * 4 + wc] = ss;
                asm volatile("" ::: "memory");
            }
    }
};

template <class Epi, class Sched, bool ALIGN_EPI = false, bool SP2 = false>
__device__ __forceinline__ void gemm_phase(PG8_LAS unsigned char* lds, const Gemm g, const Sched& S, const Epi& E) {
    int tid_ = threadIdx.x; asm volatile("" : "+v"(tid_));
    const int tid = tid_, wid = __builtin_amdgcn_readfirstlane(tid >> 6), lane = tid & 63, wr = wid >> 2, wc = wid & 3, fr = lane & 15, fq = lane >> 4;
    const int K = g.K, nt = K / BK;
    unsigned voffA[2], voffB[2];
#pragma unroll
    for (int i = 0; i < 2; ++i) { int R, C; stage_rc(tid * 16 + i * 8192, R, C); const int Rb = Epi::PERM ? ((R & ~31) + perm32(R & 31)) : R;
        voffA[i] = (unsigned)(R * K + C) * 2u; voffB[i] = (unsigned)(Rb * K + C) * 2u; }
    const size_t kstep = (size_t)(BK * 2);
    const size_t hstep = (size_t)HALF * K * 2;
    const size_t tstep = 2 * hstep;
    const unsigned ldsw = (unsigned)wid * 1024u;
    const int aoff = lds_byte(wr * 64 + fr, fq * 8), boff = lds_byte(wc * 32 + fr, fq * 8);
#define PG8_SA(b, h) (((b) * 2 + (h)) * HTB)
#define PG8_SB(b, h) ((4 + (b) * 2 + (h)) * HTB)
#define PG8_STAGE(bufoff, gbase, voff) do { _Pragma("unroll") for (int _i = 0; _i < 2; ++_i) \
        __builtin_amdgcn_global_load_lds((const unsigned*)((const char*)(gbase) + (voff)[_i]), (PG8_LAS unsigned*)(lds + (bufoff) + ldsw + _i * 8192), 16, 0, 0); } while (0)
#define PG8_LDA(dst, b, h) do { _Pragma("unroll") for (int m = 0; m < 4; ++m) _Pragma("unroll") for (int k = 0; k < 2; ++k) dst[m][k] = *(const PG8_LAS bf16x8*)(lds + PG8_SA(b, h) + aoff + m * 2048 + k * 1024); } while (0)
#define PG8_LDB(dst, b, h) do { _Pragma("unroll") for (int n = 0; n < 2; ++n) _Pragma("unroll") for (int k = 0; k < 2; ++k) dst[n][k] = *(const PG8_LAS bf16x8*)(lds + PG8_SB(b, h) + boff + n * 2048 + k * 1024); } while (0)
#define PG8_MMA(ai, bj, At, Bt) do { __builtin_amdgcn_s_setprio(1); _Pragma("unroll") for (int m = 0; m < 4; ++m) _Pragma("unroll") for (int n = 0; n < 2; ++n) _Pragma("unroll") for (int k = 0; k < 2; ++k) \
        acc[ai][bj][m][n] = __builtin_amdgcn_mfma_f32_16x16x32_bf16(Bt[n][k], At[m][k], acc[ai][bj][m][n], 0, 0, 0); __builtin_amdgcn_s_setprio(0); } while (0)
#define PG8_WAIT_V(n) asm volatile("s_waitcnt vmcnt(" #n ")" ::: "memory")
#define PG8_WAIT_L(n) asm volatile("s_waitcnt lgkmcnt(" #n ")" ::: "memory")
#define PG8_BAR __builtin_amdgcn_s_barrier()
#define PG8_SCHED __builtin_amdgcn_sched_barrier(0)
    Unit cur, nxt; int ui = 0;
    if (!S.next(0, cur)) return;
    f32x4 acc[2][2][4][2];
#pragma unroll
    for (int a = 0; a < 2; ++a)
#pragma unroll
        for (int b = 0; b < 2; ++b)
#pragma unroll
            for (int m = 0; m < 4; ++m)
#pragma unroll
                for (int n = 0; n < 2; ++n) acc[a][b][m][n] = (f32x4){0.f, 0.f, 0.f, 0.f};
    bf16x8 At[4][2], B0[2][2], B1[2][2];
    const char* cA = (const char*)g.A + (size_t)cur.pm * tstep; const char* cB = (const char*)g.Bt + (size_t)cur.pn * tstep;
    S.a_ready(cur);
    if constexpr (SP2) {
        PG8_STAGE(PG8_SB(0, 0), cB, voffB); PG8_STAGE(PG8_SB(0, 1), cB + hstep, voffB); PG8_STAGE(PG8_SA(0, 0), cA, voffA); PG8_STAGE(PG8_SA(0, 1), cA + hstep, voffA);
        if (wr == 1) PG8_BAR;
        PG8_WAIT_V(2); PG8_BAR;
        PG8_STAGE(PG8_SB(1, 0), cB + kstep, voffB); PG8_STAGE(PG8_SA(1, 0), cA + kstep, voffA); PG8_STAGE(PG8_SB(1, 1), cB + hstep + kstep, voffB);
        PG8_WAIT_V(6); PG8_BAR;
    } else {
        PG8_STAGE(PG8_SB(0, 0), cB, voffB); PG8_STAGE(PG8_SA(0, 0), cA, voffA); PG8_STAGE(PG8_SB(0, 1), cB + hstep, voffB); PG8_STAGE(PG8_SA(0, 1), cA + hstep, voffA);
        if (wr == 1) PG8_BAR;
        PG8_WAIT_V(4); PG8_BAR;
        PG8_STAGE(PG8_SB(1, 0), cB + kstep, voffB); PG8_STAGE(PG8_SA(1, 0), cA + kstep, voffA); PG8_STAGE(PG8_SB(1, 1), cB + hstep + kstep, voffB);
        PG8_WAIT_V(6); PG8_BAR;
    }
    for (;;) {
        const bool has_next = S.next(ui + 1, nxt);
        const char* nA = has_next ? (const char*)g.A + (size_t)nxt.pm * tstep : cA; const char* nB = has_next ? (const char*)g.Bt + (size_t)nxt.pn * tstep : cB;
        for (int t = 0; t < nt; t += 2) {
            const bool last = (t == nt - 2);
            if constexpr (Epi::MIDK) { if (t == (nt >> 1)) E.midk(acc, cur, wr, wc, fr, fq); }
            const char* a1 = cA + (size_t)(t + 1) * kstep;
            const char* a2 = last ? nA : cA + (size_t)(t + 2) * kstep; const char* b2 = last ? nB : cB + (size_t)(t + 2) * kstep;
            const char* a3 = a2 + kstep; const char* b3 = b2 + kstep;
            if (last && has_next) S.a_ready(nxt);
            if constexpr (SP2) {
            PG8_LDB(B0, 0, 0); PG8_LDB(B1, 0, 1); PG8_SCHED; PG8_LDA(At, 0, 0); PG8_STAGE(PG8_SA(1, 1), a1 + hstep, voffA);
            PG8_WAIT_V(8); PG8_WAIT_L(0); PG8_BAR; PG8_MMA(0, 0, At, B0); PG8_MMA(0, 1, At, B1); PG8_BAR; PG8_SCHED;
            PG8_LDA(At, 0, 1); PG8_STAGE(PG8_SB(0, 0), b2, voffB); PG8_STAGE(PG8_SB(0, 1), b2 + hstep, voffB); PG8_STAGE(PG8_SA(0, 0), a2, voffA);
            PG8_WAIT_V(8); PG8_WAIT_L(0); PG8_BAR; PG8_MMA(1, 0, At, B0); PG8_MMA(1, 1, At, B1); PG8_BAR; PG8_SCHED;
            PG8_LDB(B0, 1, 0); PG8_LDB(B1, 1, 1); PG8_SCHED; PG8_LDA(At, 1, 0); PG8_STAGE(PG8_SA(0, 1), a2 + hstep, voffA);
            PG8_WAIT_V(8); PG8_WAIT_L(0); PG8_BAR; PG8_MMA(0, 0, At, B0); PG8_MMA(0, 1, At, B1); PG8_BAR; PG8_SCHED;
            PG8_LDA(At, 1, 1); PG8_STAGE(PG8_SB(1, 0), b3, voffB); PG8_STAGE(PG8_SB(1, 1), b3 + hstep, voffB); PG8_STAGE(PG8_SA(1, 0), a3, voffA);
            PG8_WAIT_V(8); PG8_WAIT_L(0); PG8_BAR; PG8_MMA(1, 0, At, B0); PG8_MMA(1, 1, At, B1); PG8_BAR; PG8_SCHED;
            } else {
            PG8_LDB(B0, 0, 0); PG8_SCHED; PG8_LDA(At, 0, 0); PG8_STAGE(PG8_SA(1, 1), a1 + hstep, voffA);
            PG8_WAIT_L(8); PG8_BAR; PG8_WAIT_L(0); PG8_MMA(0, 0, At, B0); PG8_BAR; PG8_SCHED;
            PG8_LDB(B1, 0, 1); PG8_STAGE(PG8_SB(0, 0), b2, voffB);
            PG8_BAR; PG8_WAIT_L(0); PG8_MMA(0, 1, At, B1); PG8_BAR;
            PG8_LDA(At, 0, 1); PG8_STAGE(PG8_SA(0, 0), a2, voffA);
            PG8_BAR; PG8_WAIT_L(0); PG8_MMA(1, 0, At, B0); PG8_BAR; PG8_SCHED;
            PG8_STAGE(PG8_SB(0, 1), b2 + hstep, voffB);
            PG8_WAIT_V(6); PG8_BAR; PG8_MMA(1, 1, At, B1); PG8_BAR;
            PG8_LDB(B0, 1, 0); PG8_SCHED; PG8_LDA(At, 1, 0); PG8_STAGE(PG8_SA(0, 1), a2 + hstep, voffA);
            PG8_WAIT_L(8); PG8_BAR; PG8_WAIT_L(0); PG8_MMA(0, 0, At, B0); PG8_BAR; PG8_SCHED;
            PG8_LDB(B1, 1, 1); PG8_STAGE(PG8_SB(1, 0), b3, voffB);
            PG8_BAR; PG8_WAIT_L(0); PG8_MMA(0, 1, At, B1); PG8_BAR;
            PG8_LDA(At, 1, 1); PG8_STAGE(PG8_SA(1, 0), a3, voffA);
            PG8_BAR; PG8_WAIT_L(0); PG8_MMA(1, 0, At, B0); PG8_BAR; PG8_SCHED;
            PG8_STAGE(PG8_SB(1, 1), b3 + hstep, voffB);
            PG8_WAIT_V(6); PG8_BAR; PG8_MMA(1, 1, At, B1); PG8_BAR;
            }
        }
        if constexpr (ALIGN_EPI) { if (wr == 0) PG8_BAR; }
        if constexpr (!Epi::AFTER_DRAIN) { E(acc, cur, wr, wc, fr, fq); S.done(cur); }
        if (!has_next) break;
#pragma unroll
        for (int a = 0; a < 2; ++a)
#pragma unroll
            for (int b = 0; b < 2; ++b)
#pragma unroll
                for (int m = 0; m < 4; ++m)
#pragma unroll
                    for (int n = 0; n < 2; ++n) acc[a][b][m][n] = (f32x4){0.f, 0.f, 0.f, 0.f};
        cur = nxt; cA = nA; cB = nB; ++ui;
        if constexpr (ALIGN_EPI) { if (wr == 1) PG8_BAR; }
    }
    PG8_WAIT_V(0);
    if constexpr (!ALIGN_EPI) { if (wr == 0) PG8_BAR; }
    PG8_BAR;
    if constexpr (Epi::AFTER_DRAIN) { E.fused(acc, cur, wr, wc, fr, fq, lds, wid, lane); S.done(cur); }
#undef PG8_SA
#undef PG8_SB
#undef PG8_STAGE
#undef PG8_LDA
#undef PG8_LDB
#undef PG8_MMA
#undef PG8_WAIT_V
#undef PG8_WAIT_L
#undef PG8_BAR
#undef PG8_SCHED
}
}
#define LAS __attribute__((address_space(3)))
#define XB_TMO      128
#define XB_XCNT(j)  (256  + 64 * (j))
#define XB_XSUB(j)  (1280 + 64 * (j))
#define XB_XGEN(j)  (2304 + 64 * (j))
#define XB_TOP      3328
#define XB_TOPGEN   3392
#define XCD_BAR_WORDS 3456
#define XB_SPIN_CAP (1u << 18)

__device__ __forceinline__ unsigned xb_ld(unsigned* p)              { return __hip_atomic_load(p, __ATOMIC_RELAXED, __HIP_MEMORY_SCOPE_AGENT); }
__device__ __forceinline__ unsigned xb_add(unsigned* p, unsigned v) { return __hip_atomic_fetch_add(p, v, __ATOMIC_RELAXED, __HIP_MEMORY_SCOPE_AGENT); }
__device__ __forceinline__ unsigned xb_xcc_id() { return (unsigned)__builtin_amdgcn_s_getreg((3 << 11) | 20) & 0xFu; }
#define XB_SPIN(cond, bar) do { unsigned _sp = 0; while (cond) { __builtin_amdgcn_s_sleep(1); \
    if ((++_sp & 255u) == 0u) { if (xb_ld(&(bar)[XB_TMO])) break; if (_sp > XB_SPIN_CAP) { atomicAdd(&(bar)[XB_TMO], 1u); break; } } } } while (0)

struct XcdBarrier {
    unsigned* bar; unsigned x;
    volatile LAS unsigned* st;
};

__device__ __forceinline__ XcdBarrier xcd_barrier_post(unsigned* bar, volatile LAS unsigned* st) {
    XcdBarrier b; b.bar = bar; b.x = xb_xcc_id(); b.st = st;
    if (threadIdx.x == 0) (void)xb_add(&bar[XB_XCNT(b.x)], 1u);
    return b;
}
__device__ __forceinline__ void xcd_barrier_complete(unsigned* bar, unsigned x, unsigned& nloc, unsigned& nx) {
    const unsigned G = gridDim.x * gridDim.y * gridDim.z;
    unsigned sum, cnt, mine, sp = 0u;
    for (;;) {
        sum = 0u; cnt = 0u; mine = 0u;
#pragma unroll
        for (unsigned j = 0; j < 16; ++j) { const unsigned c = xb_ld(&bar[XB_XCNT(j)]); sum += c; cnt += (c > 0u) ? 1u : 0u; mine = (j == x) ? c : mine; }
        if (sum == G) break;
        __builtin_amdgcn_s_sleep(1);
        if ((++sp & 255u) == 0u) { if (xb_ld(&bar[XB_TMO])) break; if (sp > XB_SPIN_CAP) { atomicAdd(&bar[XB_TMO], 1u); break; } }
    }
    nloc = mine > 0u ? mine : 1u; nx = cnt > 0u ? cnt : 1u;
}

__device__ __forceinline__ void xcd_barrier(const XcdBarrier& b) {
    asm volatile("s_waitcnt vmcnt(0)" ::: "memory");
    __syncthreads();
    if (threadIdx.x == 0) {
        unsigned* bar = b.bar;
        __builtin_amdgcn_s_waitcnt(0);
        unsigned nloc = b.st[0], nx = b.st[1];
        if (nloc == 0u) { xcd_barrier_complete(bar, b.x, nloc, nx); b.st[0] = nloc; b.st[1] = nx; }
        const unsigned old = xb_add(&bar[XB_XSUB(b.x)], 1u);
        const unsigned gen = old / nloc;
        if (old + 1u == (gen + 1u) * nloc) {
            __builtin_amdgcn_fence(__ATOMIC_RELEASE, "agent");
            asm volatile("s_waitcnt vmcnt(0)" ::: "memory");
            const unsigned og = xb_add(&bar[XB_TOP], 1u);
            const unsigned tg = og / nx;
            if (og + 1u == (tg + 1u) * nx) xb_add(&bar[XB_TOPGEN], 1u);
            else XB_SPIN(xb_ld(&bar[XB_TOPGEN]) == tg, bar);
            __builtin_amdgcn_fence(__ATOMIC_ACQUIRE, "agent");
            xb_add(&bar[XB_XGEN(b.x)], 1u);
            asm volatile("s_waitcnt vmcnt(0)" ::: "memory");
        } else {
            XB_SPIN(xb_ld(&bar[XB_XGEN(b.x)]) == gen, bar);
            __builtin_amdgcn_fence(__ATOMIC_ACQUIRE, "agent");
            asm volatile("s_waitcnt vmcnt(0)" ::: "memory");
        }
    }
    __syncthreads();
}


using pg8::bf16_t; using pg8::bf16x8; using pg8::f32x4; using pg8::u32x4; using pg8::cvt_pk_bf16;
constexpr int D = 1024, NBATCH = 8, SEQ = 2048, CTXL = 256;
constexpr int ML = NBATCH * SEQ, MC = NBATCH * CTXL, MT = ML + MC;
constexpr int DIN = 2560, DFF = 4096, DL = 512, NMOD = 6144;
constexpr int NCHUNK = MT / 64;
constexpr int NTHREADS = 512;
constexpr int LDS_BYTES = 147456;

constexpr size_t MiB = 1u << 20;
constexpr size_t WS_MOD = 0;
constexpr size_t WS_BIN = WS_MOD + 2 * 9 * 6144 * 4;
constexpr size_t WS_B1  = WS_BIN + 2 * 9 * 2560 * 4;
constexpr size_t WS_LC  = WS_B1 + 2 * 9 * 4096 * 4;
constexpr size_t WS_WG  = WS_LC + 2 * 512 * 8 * 4;
constexpr size_t WS_CS  = WS_WG + 2 * 8 * 4 * 64 * 64 * 2;
constexpr size_t WS_SSQ = WS_CS + (size_t)NCHUNK * 2 * 2 * 512 * 4;
constexpr size_t WS_YSL = WS_SSQ + (size_t)MT * 16 * 4;
constexpr size_t WS_YSC = WS_YSL + (size_t)MT * 8 * 4;
constexpr size_t WS_SMALL_END = WS_YSC + (size_t)MT * 4;
static_assert(WS_SMALL_END <= 8 * MiB, "small tables");
constexpr size_t WS_BAR = 6 * MiB, BAR_ZERO_BYTES = 16384;
constexpr size_t WS_W = 8 * MiB;
constexpr size_t W_LAYER = 23 * MiB, W_IN = 0, W_OUT = 5 * MiB, W_1 = 7 * MiB, W_2 = 15 * MiB;
constexpr size_t WS_XC = 54 * MiB;
constexpr size_t WS_XS = 62 * MiB;
constexpr size_t WS_H = 98 * MiB;
constexpr size_t WS_U = 98 * MiB;
constexpr size_t WS_Y = 188 * MiB;
constexpr size_t WS_END = 242 * MiB;

struct Args { const float* in[23]; float* out; unsigned char* ws; };
enum { I_X = 0, I_C, I_CTX, I_CCTX, I_ADAW, I_ADAB, I_N1G, I_N2G, I_WIN, I_C4W, I_C4B, I_GAW, I_GAB, I_GXW, I_GXB, I_LAM, I_C3W, I_GOL, I_GOC, I_WOUT, I_W1, I_W2, I_FING };

__device__ __forceinline__ float wave_sum(float v) {
#pragma unroll
    for (int o = 1; o < 64; o <<= 1) v += __shfl_xor(v, o);
    return v;
}
__device__ __forceinline__ float sigmoid_f(float x) { return __builtin_amdgcn_rcpf(1.0f + __builtin_amdgcn_exp2f(-1.44269504089f * x)); }
__device__ __forceinline__ float gelu_tanh(float x) { const float z = 0.7978845608f * (x + 0.044715f * x * x * x); return x * sigmoid_f(2.0f * z); }
__device__ __forceinline__ void unpack8(const u32x4 w, float (&f)[8]) {
    f[0] = __uint_as_float(w.x << 16); f[1] = __uint_as_float(w.x & 0xffff0000u); f[2] = __uint_as_float(w.y << 16); f[3] = __uint_as_float(w.y & 0xffff0000u);
    f[4] = __uint_as_float(w.z << 16); f[5] = __uint_as_float(w.z & 0xffff0000u); f[6] = __uint_as_float(w.w << 16); f[7] = __uint_as_float(w.w & 0xffff0000u);
}
__device__ __forceinline__ u32x4 pack8(const float (&f)[8]) { u32x4 w; w.x = cvt_pk_bf16(f[0], f[1]); w.y = cvt_pk_bf16(f[2], f[3]); w.z = cvt_pk_bf16(f[4], f[5]); w.w = cvt_pk_bf16(f[6], f[7]); return w; }

__device__ __forceinline__ void transpose_item(const float* W, int K, int N, bf16_t* WT, const float* ks, LAS float* scr, int item, int lane) {
    const int nblk = N / 32, kb = item / nblk, nb = item % nblk, k0 = 64 * kb, n0 = 32 * nb;
#pragma unroll 8
    for (int i = 0; i < 32; ++i) { const int kk = 2 * i + (lane >> 5); float v = W[(size_t)(k0 + kk) * N + n0 + (lane & 31)]; if (ks) v *= ks[k0 + kk]; scr[kk * 33 + (lane & 31)] = v; }
    asm volatile("s_waitcnt lgkmcnt(0)" ::: "memory");
    const int c = lane & 7;
#pragma unroll
    for (int j = 0; j < 4; ++j) { const int n = (lane >> 3) + 8 * j; const LAS float* s = scr + (8 * c) * 33 + n;
        u32x4 o; o.x = cvt_pk_bf16(s[0 * 33], s[1 * 33]); o.y = cvt_pk_bf16(s[2 * 33], s[3 * 33]); o.z = cvt_pk_bf16(s[4 * 33], s[5 * 33]); o.w = cvt_pk_bf16(s[6 * 33], s[7 * 33]);
        *(u32x4*)(WT + (size_t)(n0 + n) * K + k0 + 8 * c) = o; }
    asm volatile("s_waitcnt lgkmcnt(0)" ::: "memory");
}

__device__ __forceinline__ void gemv9_item(LAS float* Sx, LAS float* red, const float* W, int N, int n0, float* out, const float* addb, int tid) {
    const int lane = tid & 63, wid = tid >> 6;
    float acc[9];
#pragma unroll
    for (int b = 0; b < 9; ++b) acc[b] = 0.f;
    const float* wp = W + (size_t)(wid * 128) * N + n0 + lane;
#pragma unroll 8
    for (int k = 0; k < 128; ++k) {
        const float wv = wp[(size_t)k * N];
        const LAS float* s = Sx + (wid * 128 + k) * 12;
        const f32x4 s0 = *(const LAS f32x4*)s, s1 = *(const LAS f32x4*)(s + 4); const float s8 = s[8];
        acc[0] += s0[0] * wv; acc[1] += s0[1] * wv; acc[2] += s0[2] * wv; acc[3] += s0[3] * wv;
        acc[4] += s1[0] * wv; acc[5] += s1[1] * wv; acc[6] += s1[2] * wv; acc[7] += s1[3] * wv; acc[8] += s8 * wv;
    }
#pragma unroll
    for (int b = 0; b < 9; ++b) red[(wid * 9 + b) * 64 + lane] = acc[b];
    __syncthreads();
    for (int idx = tid; idx < 576; idx += NTHREADS) {
        const int b = idx >> 6, ln = idx & 63; float s = 0.f;
#pragma unroll
        for (int w = 0; w < 8; ++w) s += red[(w * 9 + b) * 64 + ln];
        out[(size_t)b * N + n0 + ln] = s + (addb ? addb[n0 + ln] : 0.f);
    }
    __syncthreads();
}

struct MixP { const bf16_t* U; bf16_t* Y; float* CS; float* YSL; float* YSC; const bf16_t* WG; const float* LC; const float* c4w; const float* c4b; const float* c3w; };
__device__ __forceinline__ void lru_load_taps(const bf16_t* U, int cgi, int h, int t1, int c8, u32x4 (&un)[4]) {
    const bool is_ctx = cgi >= 256;
    const int j = is_ctx ? ((cgi - 256) & 3) : (cgi & 31), slen = is_ctx ? CTXL : SEQ, ts0 = j * 64 + t1;
    const bf16_t* base = U + (size_t)(cgi * 64 + t1) * DIN + h * 64 + c8;
#pragma unroll
    for (int k = 0; k < 4; ++k) { const int ts = ts0 + k - 1; const int d = (ts >= 0 && ts < slen) ? (k - 1) : 0; un[k] = *(const u32x4*)(base + (ptrdiff_t)d * DIN); }
}

#define LBAR() do { asm volatile("s_waitcnt lgkmcnt(0)" ::: "memory"); __builtin_amdgcn_s_barrier(); asm volatile("" ::: "memory"); } while (0)
template <bool APPLY>
__device__ __forceinline__ void lru_phase(LAS unsigned char* lds, const MixP& P, int n_units, int bx, int G, int tid) {
    const int lane = tid & 63, wid = tid >> 6;
    LAS bf16_t* Vb = (LAS bf16_t*)lds;
    LAS float* Vf = (LAS float*)(lds + 9216);
    LAS float* AF = Vf + 64 * 68; LAS float* BF = AF + 64 * 68; LAS float* AR = BF + 64 * 68; LAS float* BR = AR + 64 * 68;
    LAS float* C4 = BR + 64 * 68;
    LAS float* LCs = C4 + 320;
    LAS float* SEG = LCs + 512;
    LAS float* LBC = SEG + 2048;
    const int t1 = tid >> 3, c8 = (tid & 7) * 8;
    const int fr = lane & 15, fq = lane >> 4, mt = wid >> 1, tt = 16 * mt + fr;
    int hcur = -1;
    bf16x8 wf[2][4][2];
    u32x4 un[4];
    int it = bx;
    if (it < n_units) lru_load_taps(P.U, it >> 3, it & 7, t1, c8, un);
    for (; it < n_units; it += G) {
        const int cgi = it >> 3, h = it & 7;
        const bool is_ctx = cgi >= 256;
        const int row0 = cgi * 64;
        const int bidx = is_ctx ? ((cgi - 256) >> 2) : (cgi >> 5);
        const int j = is_ctx ? ((cgi - 256) & 3) : (cgi & 31);
        const int tseq0 = j * 64, slen = is_ctx ? CTXL : SEQ;
        if (h != hcur) {
            hcur = h;
            const bf16_t* wg = P.WG + (size_t)h * 4 * 4096;
#pragma unroll
            for (int cqi = 0; cqi < 2; ++cqi)
#pragma unroll
                for (int g = 0; g < 4; ++g)
#pragma unroll
                    for (int ks = 0; ks < 2; ++ks) wf[cqi][g][ks] = *(const bf16x8*)(wg + g * 4096 + (16 * (2 * (wid & 1) + cqi) + fr) * 64 + ks * 32 + fq * 8);
            if (tid < 320) { const int k = tid >> 6, c = tid & 63; C4[tid] = k < 4 ? P.c4w[k * DL + h * 64 + c] : P.c4b[h * 64 + c]; }
            LCs[tid] = P.LC[(size_t)h * 512 + tid];
            __syncthreads();
        }
        u32x4 gn = (u32x4){0u, 0u, 0u, 0u};
        float lp[2][5], lh[2][5];
        if (APPLY) {
            gn = *(const u32x4*)(P.U + (size_t)(row0 + t1) * DIN + DL + h * 64 + c8);
            const int cbase = 256 + 4 * bidx, sbase = is_ctx ? cbase : 32 * bidx, sn = is_ctx ? 4 : 32;
#pragma unroll
            for (int d = 0; d < 2; ++d)
#pragma unroll
                for (int e = 0; e < 5; ++e) {
                    const int s = 5 * wid + e;
                    int id; bool valid;
                    if (s < 4) { id = cbase + (d == 0 ? s : 3 - s); valid = !is_ctx; }
                    else { const int c = d == 0 ? (s - 4) : (sn - 1 - (s - 4)); valid = (s < 36) && (d == 0 ? (c < j) : (c > j)); id = sbase + (valid ? c : j); }
                    const float* p = P.CS + (size_t)id * 2048 + d * 1024 + h * 64 + lane;
                    const float pv = p[0], hv = p[512];
                    lp[d][e] = valid ? pv : 1.f; lh[d][e] = valid ? hv : 0.f;
                }
        }
        {
            float v[8];
            { const f32x4 b0 = *(const LAS f32x4*)(C4 + 256 + c8), b1 = *(const LAS f32x4*)(C4 + 256 + c8 + 4); v[0] = b0[0]; v[1] = b0[1]; v[2] = b0[2]; v[3] = b0[3]; v[4] = b1[0]; v[5] = b1[1]; v[6] = b1[2]; v[7] = b1[3]; }
#pragma unroll
            for (int k = 0; k < 4; ++k) {
                const int ts = tseq0 + t1 + k - 1;
                const float msk = (ts >= 0 && ts < slen) ? 1.f : 0.f;
                float uf[8]; unpack8(un[k], uf);
                const f32x4 w0 = *(const LAS f32x4*)(C4 + k * 64 + c8) * msk, w1 = *(const LAS f32x4*)(C4 + k * 64 + c8 + 4) * msk;
                v[0] += w0[0] * uf[0]; v[1] += w0[1] * uf[1]; v[2] += w0[2] * uf[2]; v[3] += w0[3] * uf[3];
                v[4] += w1[0] * uf[4]; v[5] += w1[1] * uf[5]; v[6] += w1[2] * uf[6]; v[7] += w1[3] * uf[7];
            }
            *(LAS u32x4*)(Vb + t1 * 72 + c8) = pack8(v);
            *(LAS f32x4*)(Vf + t1 * 68 + c8) = (f32x4){v[0], v[1], v[2], v[3]};
            *(LAS f32x4*)(Vf + t1 * 68 + c8 + 4) = (f32x4){v[4], v[5], v[6], v[7]};
        }
        if (it + G < n_units) lru_load_taps(P.U, (it + G) >> 3, (it + G) & 7, t1, c8, un);
        if (APPLY) {
#pragma unroll
            for (int d = 0; d < 2; ++d) {
                float cp = 1.f, chh = 0.f;
#pragma unroll
                for (int e = 0; e < 5; ++e) { chh = lp[d][e] * chh + lh[d][e]; cp *= lp[d][e]; }
                LBC[(d * 8 + wid) * 128 + lane] = cp; LBC[(d * 8 + wid) * 128 + 64 + lane] = chh;
            }
        }
        LBAR();
        {
            bf16x8 vfrag[2];
#pragma unroll
            for (int ks = 0; ks < 2; ++ks) vfrag[ks] = *(const LAS bf16x8*)(Vb + tt * 72 + ks * 32 + fq * 8);
#pragma unroll
            for (int cqi = 0; cqi < 2; ++cqi) {
                const int cq = 2 * (wid & 1) + cqi;
                f32x4 acc[4];
#pragma unroll
                for (int g = 0; g < 4; ++g) {
                    acc[g] = (f32x4){0.f, 0.f, 0.f, 0.f};
#pragma unroll
                    for (int ks = 0; ks < 2; ++ks) acc[g] = __builtin_amdgcn_mfma_f32_16x16x32_bf16(wf[cqi][g][ks], vfrag[ks], acc[g], 0, 0, 0);
                }
                const int c0 = 16 * cq + 4 * fq;
                const f32x4 vv = *(const LAS f32x4*)(Vf + tt * 68 + c0);
                f32x4 af, bf, ar, br;
#pragma unroll
                for (int r = 0; r < 4; ++r) {
                    const f32x4 l0 = *(const LAS f32x4*)(LCs + (c0 + r) * 8), l1 = *(const LAS f32x4*)(LCs + (c0 + r) * 8 + 4);
                    { const float rr = sigmoid_f(acc[0][r] + l0[0]), ii = sigmoid_f(acc[1][r] + l0[1]); const float a = __builtin_amdgcn_exp2f(-l0[2] * rr);
                      af[r] = a; bf[r] = __builtin_amdgcn_sqrtf(fmaxf(1.0f - a * a, 0.f)) * (ii * vv[r]); }
                    { const float rr = sigmoid_f(acc[2][r] + l0[3]), ii = sigmoid_f(acc[3][r] + l1[0]); const float a = __builtin_amdgcn_exp2f(-l1[1] * rr);
                      ar[r] = a; br[r] = __builtin_amdgcn_sqrtf(fmaxf(1.0f - a * a, 0.f)) * (ii * vv[r]); }
                }
                *(LAS f32x4*)(AF + tt * 68 + c0) = af; *(LAS f32x4*)(BF + tt * 68 + c0) = bf; *(LAS f32x4*)(AR + tt * 68 + c0) = ar; *(LAS f32x4*)(BR + tt * 68 + c0) = br;
            }
        }
        LBAR();
        {
            float aF[8], bF[8], aR[8], bR[8];
#pragma unroll
            for (int i = 0; i < 8; ++i) { const int o = (8 * wid + i) * 68 + lane; aF[i] = AF[o]; bF[i] = BF[o]; aR[i] = AR[o]; bR[i] = BR[o]; }
            float pf = 1.f, hf = 0.f, pr = 1.f, hr = 0.f;
#pragma unroll
            for (int i = 0; i < 8; ++i) { hf = aF[i] * hf + bF[i]; pf *= aF[i]; hr = aR[7 - i] * hr + bR[7 - i]; pr *= aR[7 - i]; }
            SEG[(0 * 8 + wid) * 128 + lane] = pf; SEG[(0 * 8 + wid) * 128 + 64 + lane] = hf; SEG[(1 * 8 + wid) * 128 + lane] = pr; SEG[(1 * 8 + wid) * 128 + 64 + lane] = hr;
            LBAR();
            if (APPLY) {
                float sp[8], sh[8], rp[8], rh[8];
#pragma unroll
                for (int v = 0; v < 8; ++v) { sp[v] = SEG[(0 * 8 + v) * 128 + lane]; sh[v] = SEG[(0 * 8 + v) * 128 + 64 + lane]; rp[v] = SEG[(1 * 8 + v) * 128 + lane]; rh[v] = SEG[(1 * 8 + v) * 128 + 64 + lane]; }
                float cf = 0.f, cr = 0.f;
#pragma unroll
                for (int v = 0; v < 8; ++v) { cf = LBC[(0 * 8 + v) * 128 + lane] * cf + LBC[(0 * 8 + v) * 128 + 64 + lane]; cr = LBC[(1 * 8 + v) * 128 + lane] * cr + LBC[(1 * 8 + v) * 128 + 64 + lane]; }
#pragma unroll
                for (int v = 0; v < 8; ++v) { if (v < wid) cf = sp[v] * cf + sh[v]; if (7 - v > wid) cr = rp[7 - v] * cr + rh[7 - v]; }
#pragma unroll
                for (int i = 0; i < 8; ++i) { cf = aF[i] * cf + bF[i]; bF[i] = cf; cr = aR[7 - i] * cr + bR[7 - i]; bR[7 - i] = cr; }
#pragma unroll
                for (int i = 0; i < 8; ++i) { const int o = (8 * wid + i) * 68 + lane; BF[o] = bF[i]; BR[o] = bR[i]; }
            } else if (wid < 2) {
                float pp = 1.f, hh = 0.f;
#pragma unroll
                for (int v = 0; v < 8; ++v) { const int sv = wid == 0 ? v : 7 - v; const float p = SEG[(wid * 8 + sv) * 128 + lane], q = SEG[(wid * 8 + sv) * 128 + 64 + lane]; hh = p * hh + q; pp *= p; }
                float* cs = P.CS + (size_t)cgi * 2048 + wid * 1024 + h * 64 + lane; cs[0] = pp; cs[512] = hh;
            }
        }
        if (APPLY) {
            LBAR();
            const int row = row0 + t1;
            float gf[8]; unpack8(gn, gf);
            const f32x4 f0 = *(const LAS f32x4*)(BF + t1 * 68 + c8), f1 = *(const LAS f32x4*)(BF + t1 * 68 + c8 + 4);
            const f32x4 r0 = *(const LAS f32x4*)(BR + t1 * 68 + c8), r1 = *(const LAS f32x4*)(BR + t1 * 68 + c8 + 4);
            float y[8]; float ss = 0.f;
#pragma unroll
            for (int q = 0; q < 4; ++q) { y[q] = gelu_tanh(gf[q]) * (f0[q] + r0[q]); y[q + 4] = gelu_tanh(gf[q + 4]) * (f1[q] + r1[q]); }
#pragma unroll
            for (int q = 0; q < 8; ++q) ss += y[q] * y[q];
            *(u32x4*)(P.Y + (size_t)row * D + h * 64 + c8) = pack8(y);
            ss += __shfl_xor(ss, 1); ss += __shfl_xor(ss, 2); ss += __shfl_xor(ss, 4);
            if ((tid & 7) == 0) P.YSL[(size_t)row * 8 + h] = ss;
        }
        LBAR();
    }
}

__device__ __forceinline__ void conv_unit(const MixP& P, int cgi, int tid) {
    const bool is_ctx = cgi >= 256;
    const int tok = tid >> 3, sub = tid & 7, row = cgi * 64 + tok;
    const int tseq = (is_ctx ? ((cgi - 256) & 3) : (cgi & 31)) * 64 + tok;
    const bf16_t* ur = P.U + (size_t)row * DIN;
    float ss = 0.f;
#pragma unroll 4
    for (int q = 0; q < 8; ++q) {
        const int ch = q * 64 + sub * 8;
        int d; bool vm, vp;
        if (is_ctx) { d = 1; vm = tseq >= 1; vp = tseq + 1 < CTXL; }
        else if (q < 4) { d = 1; vm = tok >= 1; vp = tok < 63; }
        else { d = 64; vm = tseq >= 64; vp = tseq + 64 < SEQ; }
        const bf16_t* um = ur - (vm ? (ptrdiff_t)d * DIN : 0); const bf16_t* up = ur + (vp ? (ptrdiff_t)d * DIN : 0);
        const u32x4 xc0 = *(const u32x4*)(ur + 1024 + ch), cc0 = *(const u32x4*)(ur + 2048 + ch), xm0 = *(const u32x4*)(um + 1024 + ch), cm0 = *(const u32x4*)(um + 2048 + ch);
        const u32x4 xp0 = *(const u32x4*)(up + 1024 + ch), cp0 = *(const u32x4*)(up + 2048 + ch), bg0 = *(const u32x4*)(ur + 1536 + ch);
        const float mm = vm ? 1.f : 0.f, mp = vp ? 1.f : 0.f;
        float acc[8], xa[8], ca[8];
        { unpack8(xc0, xa); unpack8(cc0, ca);
          const f32x4 w0 = *(const f32x4*)(P.c3w + DL + ch), w1 = *(const f32x4*)(P.c3w + DL + ch + 4);
#pragma unroll
          for (int i = 0; i < 4; ++i) { acc[i] = w0[i] * (xa[i] * ca[i]); acc[i + 4] = w1[i] * (xa[i + 4] * ca[i + 4]); } }
        { unpack8(xm0, xa); unpack8(cm0, ca);
          const f32x4 w0 = *(const f32x4*)(P.c3w + ch) * mm, w1 = *(const f32x4*)(P.c3w + ch + 4) * mm;
#pragma unroll
          for (int i = 0; i < 4; ++i) { acc[i] += w0[i] * (xa[i] * ca[i]); acc[i + 4] += w1[i] * (xa[i + 4] * ca[i + 4]); } }
        { unpack8(xp0, xa); unpack8(cp0, ca);
          const f32x4 w0 = *(const f32x4*)(P.c3w + 2 * DL + ch) * mp, w1 = *(const f32x4*)(P.c3w + 2 * DL + ch + 4) * mp;
#pragma unroll
          for (int i = 0; i < 4; ++i) { acc[i] += w0[i] * (xa[i] * ca[i]); acc[i + 4] += w1[i] * (xa[i + 4] * ca[i + 4]); } }
        float bg[8]; unpack8(bg0, bg);
#pragma unroll
        for (int i = 0; i < 8; ++i) { acc[i] *= bg[i]; ss += acc[i] * acc[i]; }
        *(u32x4*)(P.Y + (size_t)row * D + DL + ch) = pack8(acc);
    }
    ss += __shfl_xor(ss, 1); ss += __shfl_xor(ss, 2); ss += __shfl_xor(ss, 4);
    if (sub == 0) P.YSC[row] = ss;
}

__global__ void __launch_bounds__(NTHREADS, 2) fwd_megakernel(Args args) {
    extern __shared__ __attribute__((aligned(16))) unsigned char lds_raw[];
    LAS unsigned char* lds = (LAS unsigned char*)lds_raw;
    const int tid = threadIdx.x, lane = tid & 63, wid = __builtin_amdgcn_readfirstlane(tid >> 6);
    const int G = gridDim.x, bx = blockIdx.x;
    unsigned char* ws = args.ws;
    float* MOD = (float*)(ws + WS_MOD); float* BIN = (float*)(ws + WS_BIN); float* B1 = (float*)(ws + WS_B1); float* LC = (float*)(ws + WS_LC);
    bf16_t* WG = (bf16_t*)(ws + WS_WG); float* CS = (float*)(ws + WS_CS); float* SSQ = (float*)(ws + WS_SSQ); float* YSL = (float*)(ws + WS_YSL); float* YSC = (float*)(ws + WS_YSC);
    float* XC = (float*)(ws + WS_XC); bf16_t* XS = (bf16_t*)(ws + WS_XS); bf16_t* HB = (bf16_t*)(ws + WS_H); bf16_t* U = (bf16_t*)(ws + WS_U); bf16_t* Y = (bf16_t*)(ws + WS_Y);
    const int gw = bx * 8 + wid, NGW = G * 8;
    volatile LAS unsigned* bst = (volatile LAS unsigned*)(lds + 131072 + 64);
    if (tid < 2) bst[tid] = 0u;
    __syncthreads();
    (void)xcd_barrier_post((unsigned*)(ws + WS_BAR), bst);
#define GRID_BAR() do { XcdBarrier b_; b_.bar = (unsigned*)(ws + WS_BAR); b_.x = xb_xcc_id(); b_.st = bst; xcd_barrier(b_); } while (0)

    {
        LAS float* Sx = (LAS float*)lds; LAS float* red = (LAS float*)(lds + 49152);
        bool loaded = false;
        for (int it = bx; it < 2 * (NMOD / 64); it += G) {
            if (!loaded) {
                for (int idx = tid; idx < 9 * 1024; idx += NTHREADS) { const int b = idx >> 10, k = idx & 1023; const float c = b < 8 ? args.in[I_C][b * 1024 + k] : args.in[I_CCTX][k]; Sx[k * 12 + b] = c * sigmoid_f(c); }
                __syncthreads(); loaded = true;
            }
            const int l = it / (NMOD / 64), n0 = (it % (NMOD / 64)) * 64;
            gemv9_item(Sx, red, args.in[I_ADAW] + (size_t)l * D * NMOD, NMOD, n0, MOD + (size_t)l * 9 * NMOD, args.in[I_ADAB] + (size_t)l * NMOD, tid);
        }
        __syncthreads();
        LAS float* scr = (LAS float*)(lds + wid * 16384);
        constexpr int T_IN = (D / 64) * (DIN / 32), T_OUT = (D / 64) * (D / 32), T_1 = (D / 64) * (DFF / 32), T_2 = (DFF / 64) * (D / 32), T_L = T_IN + T_OUT + T_1 + T_2;
        for (int it = gw; it < 2 * T_L; it += NGW) {
            const int l = it / T_L; int r = it % T_L;
            bf16_t* wl = (bf16_t*)(ws + WS_W + (size_t)l * W_LAYER);
            if (r < T_IN) { transpose_item(args.in[I_WIN] + (size_t)l * D * DIN, D, DIN, (bf16_t*)((unsigned char*)wl + W_IN), nullptr, scr, r, lane); continue; } r -= T_IN;
            if (r < T_OUT) {
                const int kb = r / (D / 32); const float* ks = kb < 8 ? args.in[I_GOL] + (size_t)l * DL : args.in[I_GOC] + (size_t)l * DL - DL;
                transpose_item(args.in[I_WOUT] + (size_t)l * D * D, D, D, (bf16_t*)((unsigned char*)wl + W_OUT), ks, scr, r, lane); continue; } r -= T_OUT;
            if (r < T_1) { transpose_item(args.in[I_W1] + (size_t)l * D * DFF, D, DFF, (bf16_t*)((unsigned char*)wl + W_1), nullptr, scr, r, lane); continue; } r -= T_1;
            transpose_item(args.in[I_W2] + (size_t)l * DFF * D, DFF, D, (bf16_t*)((unsigned char*)wl + W_2), nullptr, scr, r, lane);
        }
        for (int idx = bx * NTHREADS + tid; idx < 2 * 8 * 4 * 64 * 64; idx += G * NTHREADS) {
            const int d = idx & 63, e = (idx >> 6) & 63, g = (idx >> 12) & 3, h = (idx >> 14) & 7, l = idx >> 17;
            const float* src = (g & 1) ? args.in[I_GXW] : args.in[I_GAW];
            const float v = src[((size_t)((l * 2 + (g >> 1)) * 8 + h) * 64 + d) * 64 + e];
            WG[idx] = (bf16_t)(cvt_pk_bf16(v, 0.f) & 0xffffu);
        }
        for (int idx = bx * NTHREADS + tid; idx < 2 * DL; idx += G * NTHREADS) {
            const int l = idx / DL, ch = idx % DL; float* lc = LC + (size_t)idx * 8;
            const float lf = args.in[I_LAM][(l * 2 + 0) * DL + ch], lr = args.in[I_LAM][(l * 2 + 1) * DL + ch];
            lc[0] = args.in[I_GAB][(l * 2 + 0) * DL + ch]; lc[1] = args.in[I_GXB][(l * 2 + 0) * DL + ch]; lc[2] = 8.0f * log1pf(expf(-lf)) * 1.44269504089f;
            lc[3] = args.in[I_GAB][(l * 2 + 1) * DL + ch]; lc[4] = args.in[I_GXB][(l * 2 + 1) * DL + ch]; lc[5] = 8.0f * log1pf(expf(-lr)) * 1.44269504089f;
            lc[6] = 0.f; lc[7] = 0.f;
        }
    }
    cg::this_grid().sync();
    {
        LAS float* Sx = (LAS float*)lds; LAS float* red = (LAS float*)(lds + 49152);
        constexpr int NI_IN = DIN / 64, NI_1 = DFF / 64, NI_L = NI_IN + NI_1;
        for (int it = bx; it < 2 * NI_L; it += G) {
            const int l = it / NI_L, r = it % NI_L; const bool is1 = r >= NI_IN;
            const float* sh = MOD + (size_t)l * 9 * NMOD + (is1 ? 3 * D : 0);
            __syncthreads();
            for (int idx = tid; idx < 9 * 1024; idx += NTHREADS) { const int b = idx >> 10, k = idx & 1023; Sx[k * 12 + b] = sh[(size_t)b * NMOD + k]; }
            __syncthreads();
            if (!is1) gemv9_item(Sx, red, args.in[I_WIN] + (size_t)l * D * DIN, DIN, r * 64, BIN + (size_t)l * 9 * DIN, nullptr, tid);
            else gemv9_item(Sx, red, args.in[I_W1] + (size_t)l * D * DFF, DFF, (r - NI_IN) * 64, B1 + (size_t)l * 9 * DFF, nullptr, tid);
        }
        for (int m = gw; m < MT; m += NGW) {
            const bool lat = m < ML; const int b = lat ? m / SEQ : 8;
            const float* xr = lat ? args.in[I_X] + (size_t)m * D : args.in[I_CTX] + (size_t)(m - ML) * D;
            const float* sc = MOD + (size_t)b * NMOD + D; const float* ng = args.in[I_N1G];
            float s = 0.f;
#pragma unroll
            for (int q = 0; q < 4; ++q) {
                const int c = q * 256 + lane * 4;
                const f32x4 v = *(const f32x4*)(xr + c), g = *(const f32x4*)(ng + c), sv = *(const f32x4*)(sc + c);
                s += (v[0] * v[0] + v[1] * v[1]) + (v[2] * v[2] + v[3] * v[3]);
                const f32x4 z = v * (g * (sv + 1.0f));
                unsigned long long o = (unsigned long long)cvt_pk_bf16(z[0], z[1]) | ((unsigned long long)cvt_pk_bf16(z[2], z[3]) << 32);
                *(unsigned long long*)(XS + (size_t)m * D + c) = o;
            }
            s = wave_sum(s);
            if (lane < 16) SSQ[(size_t)m * 16 + lane] = lane == 0 ? s : 0.f;
        }
    }
    GRID_BAR();

#pragma nounroll
    for (int l = 0; l < 2; ++l) {
        const bool lastl = (l == 1);
        const float* modl = MOD + (size_t)l * 9 * NMOD;
        const unsigned char* wl = ws + WS_W + (size_t)l * W_LAYER;
        const int nMall = lastl ? 64 : 72;
        {
            pg8::Gemm g{XS, (const bf16_t*)(wl + W_IN), MT, DIN, D};
            pg8::Order S; S.init(nMall, DIN / 256, G, bx, 64, lastl ? 16 : 0);
            pg8::EpiLin<0> E{U, DIN, BIN + (size_t)l * 9 * DIN, DIN, SSQ};
            pg8::gemm_phase<pg8::EpiLin<0>, pg8::Order, true, true>(lds, g, S, E);
        }
        GRID_BAR();
        MixP P{U, Y, CS, YSL, YSC, WG + (size_t)l * 8 * 4 * 4096, LC + (size_t)l * DL * 8, args.in[I_C4W] + (size_t)l * 4 * DL, args.in[I_C4B] + (size_t)l * DL, args.in[I_C3W] + (size_t)l * 3 * DL};
        {
            const int n_lru = NCHUNK * 8, n_conv = lastl ? 256 : NCHUNK;
            int mtid = threadIdx.x; asm volatile("" : "+v"(mtid));
            lru_phase<false>(lds, P, n_lru, bx, G, mtid);
            for (int it = bx; it < n_conv; it += G) conv_unit(P, it, mtid);
        }
        GRID_BAR();
        {
            const int n_lru = (lastl ? 256 : NCHUNK) * 8;
            int mtid = threadIdx.x; asm volatile("" : "+v"(mtid));
            lru_phase<true>(lds, P, n_lru, bx, G, mtid);
        }
        GRID_BAR();
        {
            pg8::Gemm g{Y, (const bf16_t*)(wl + W_OUT), MT, D, D};
            pg8::Order S; S.init(nMall, D / 256, G, bx, 0, 0);
            pg8::EpiRes<true> E{l == 0 ? args.in[I_X] : args.out, l == 0 ? args.in[I_CTX] : XC, args.out, XC, modl + 2 * D, modl + 4 * D, args.in[I_N2G] + (size_t)l * D, XS, SSQ, YSL, YSC};
            pg8::gemm_phase<pg8::EpiRes<true>, pg8::Order, true, true>(lds, g, S, E);
        }
        GRID_BAR();
        {
            pg8::Gemm g{XS, (const bf16_t*)(wl + W_1), MT, DFF, D};
            pg8::Order S; S.init(nMall, DFF / 256, G, bx, 0, 0);
            pg8::EpiLin<1> E{HB, DFF, B1 + (size_t)l * 9 * DFF, DFF, SSQ};
            pg8::gemm_phase<pg8::EpiLin<1>, pg8::Order, true, true>(lds, g, S, E);
        }
        GRID_BAR();
        {
            pg8::Gemm g{HB, (const bf16_t*)(wl + W_2), MT, D, DFF};
            pg8::Order S; S.init(nMall, D / 256, G, bx, 0, 0);
            const float* nsc = lastl ? nullptr : (MOD + (size_t)(l + 1) * 9 * NMOD + D);
            pg8::EpiRes<false> E{args.out, XC, args.out, XC, modl + 5 * D, nsc, args.in[I_N1G] + (size_t)(lastl ? 0 : (l + 1)) * D, XS, SSQ, YSL, YSC};
            pg8::gemm_phase<pg8::EpiRes<false>, pg8::Order, true, true>(lds, g, S, E);
        }
        GRID_BAR();
    }
    int flane = threadIdx.x; asm volatile("" : "+v"(flane)); flane &= 63;
    for (int m = gw; m < ML; m += NGW) {
        const f32x4 a = *(const f32x4*)(SSQ + (size_t)m * 16), b = *(const f32x4*)(SSQ + (size_t)m * 16 + 4), c = *(const f32x4*)(SSQ + (size_t)m * 16 + 8), d = *(const f32x4*)(SSQ + (size_t)m * 16 + 12);
        const float s = (((a[0] + a[1]) + (a[2] + a[3])) + ((b[0] + b[1]) + (b[2] + b[3]))) + (((c[0] + c[1]) + (c[2] + c[3])) + ((d[0] + d[1]) + (d[2] + d[3])));
        const float rs = 1.0f / sqrtf(s * (1.0f / 1024.0f) + pg8::RMS_EPS);
        float* xr = args.out + (size_t)m * D;
#pragma unroll
        for (int q = 0; q < 4; ++q) { const int cc = q * 256 + flane * 4; const f32x4 v = *(const f32x4*)(xr + cc), g = *(const f32x4*)(args.in[I_FING] + cc); *(f32x4*)(xr + cc) = v * rs * g; }
    }
}

extern "C" void kernel_launch(void* const* d_in, const int* in_sizes, int n_in, void* d_out, int out_size, void* d_ws, size_t ws_size, hipStream_t stream) {
    static int grid_blocks = 0;
    if (grid_blocks == 0) {
        if (n_in != 23 || out_size != ML * D || ws_size < WS_END) { fprintf(stderr, "kernel_launch: unexpected problem (n_in %d out %d ws %zu)\n", n_in, out_size, ws_size); grid_blocks = -1; return; }
        int dev = 0, cus = 0, per_cu = 0;
        hipGetDevice(&dev);
        hipDeviceGetAttribute(&cus, hipDeviceAttributeMultiprocessorCount, dev);
        if (hipFuncSetAttribute((const void*)fwd_megakernel, hipFuncAttributeMaxDynamicSharedMemorySize, LDS_BYTES) != hipSuccess) { fprintf(stderr, "kernel_launch: hipFuncSetAttribute failed\n"); grid_blocks = -1; return; }
        if (hipOccupancyMaxActiveBlocksPerMultiprocessor(&per_cu, (const void*)fwd_megakernel, NTHREADS, LDS_BYTES) != hipSuccess || per_cu < 1) { fprintf(stderr, "kernel_launch: occupancy query failed (%d)\n", per_cu); per_cu = 1; }
        (void)hipGetLastError();
        grid_blocks = cus * 1;
        fprintf(stderr, "kernel_launch: cus %d per_cu %d grid %d\n", cus, per_cu, grid_blocks);
    }
    if (grid_blocks < 0) return;
    if (hipMemsetAsync((unsigned char*)d_ws + WS_BAR, 0, BAR_ZERO_BYTES, stream) != hipSuccess) { fprintf(stderr, "kernel_launch: memset failed\n"); return; }
    Args a{};
    for (int i = 0; i < 23; ++i) a.in[i] = (const float*)d_in[i];
    a.out = (float*)d_out; a.ws = (unsigned char*)d_ws;
    void* kargs[] = {&a};
    hipError_t e = hipLaunchCooperativeKernel((const void*)fwd_megakernel, dim3(grid_blocks), dim3(NTHREADS), kargs, LDS_BYTES, stream);
    if (e != hipSuccess) fprintf(stderr, "kernel_launch: cooperative launch failed: %s (grid %d)\n", hipGetErrorString(e), grid_blocks);
}
```
